# Optimizing an MI355X kernel written in HIP

```python
import jax, jax.numpy as jnp
from jax import lax
import numpy as np

D_MODEL = 1024
BATCH = 16
SEQ = 256
DEPTH = 1
DEC_BATCH = 8
DEC_SEQ = 4096
PAST_LEN = 512

GRID_W = 64
CONV_WIDTH = D_MODEL // 2
DN_HEADS = 4
DN_DK = (D_MODEL // 2) // DN_HEADS
DN_DV = (D_MODEL // 2) // DN_HEADS
DN_KEY = DN_HEADS * DN_DK
DN_VAL = DN_HEADS * DN_DV
CHUNK = 64
D_FF = 2816
N_MOD = 9
EPS = 1e-6
PROJ_DIM = 3 * CONV_WIDTH + 2 * DN_KEY + 2 * DN_VAL + 4 * DN_HEADS
SPLITS = [CONV_WIDTH, 2 * CONV_WIDTH, 3 * CONV_WIDTH,
          3 * CONV_WIDTH + 2 * DN_KEY + DN_VAL,
          3 * CONV_WIDTH + 2 * DN_KEY + 2 * DN_VAL]

kernel_name = "hybrid_conv_gdn_macaron_diffusion_step"


def _rmsnorm(x, g):
    xf = x.astype(jnp.float32)
    y = xf * lax.rsqrt(jnp.mean(xf * xf, axis=-1, keepdims=True) + EPS)
    return (y * g.astype(jnp.float32)).astype(x.dtype)


def _l2norm(x):
    return x * lax.rsqrt(jnp.sum(x * x, axis=-1, keepdims=True) + EPS)


def _conv3(x, w):
    zeros = jnp.zeros_like(x[:, :1])
    prev = jnp.concatenate([zeros, x[:, :-1]], axis=1)
    nxt = jnp.concatenate([x[:, 1:], zeros], axis=1)
    return prev * w[0] + x * w[1] + nxt * w[2]


def _swiglu(h, w_in, w_out):
    a, b = jnp.split(h @ w_in, 2, axis=-1)
    return (jax.nn.silu(a) * b) @ w_out


def _gated_delta(q, k, v, beta, g, s0):
    B, L, H, DK = q.shape
    n = L // CHUNK
    to_c = lambda t: t.reshape(B, n, CHUNK, H, -1).transpose(1, 0, 3, 2, 4)
    to_s = lambda t: t.reshape(B, n, CHUNK, H).transpose(1, 0, 3, 2)
    qc, kc, vc = to_c(q * (DK ** -0.5)), to_c(k), to_c(v)
    bc = to_s(beta)
    gc = jnp.cumsum(to_s(g), axis=-1)
    tril = jnp.tril(jnp.ones((CHUNK, CHUNK), bool))
    strict = jnp.tril(jnp.ones((CHUNK, CHUNK), bool), -1)
    diff = gc[..., :, None] - gc[..., None, :]
    decay = jnp.where(tril, jnp.exp(jnp.where(tril, diff, 0.0)), 0.0)
    kb = kc * bc[..., None]
    lmat = jnp.where(strict, jnp.einsum('nbhcd,nbhed->nbhce', kb, kc) * decay, 0.0)
    eye = jnp.eye(CHUNK, dtype=jnp.float32)
    tmat = lax.linalg.triangular_solve(eye + lmat, jnp.broadcast_to(eye, lmat.shape),
                                       left_side=True, lower=True, unit_diagonal=True)
    u = tmat @ (vc * bc[..., None])
    wk = tmat @ (kb * jnp.exp(gc)[..., None])
    qk = jnp.where(tril, jnp.einsum('nbhcd,nbhed->nbhce', qc, kc) * decay, 0.0)
    qg = qc * jnp.exp(gc)[..., None]
    kg = kc * jnp.exp(gc[..., -1:] - gc)[..., None]
    g_last = jnp.exp(gc[..., -1])

    def step(s, inp):
        qg_i, kg_i, u_i, w_i, qk_i, gl_i = inp
        v_new = u_i - w_i @ s
        o = qg_i @ s + qk_i @ v_new
        s = s * gl_i[..., None, None] + jnp.einsum('bhcd,bhce->bhde', kg_i, v_new)
        return s, o

    s_fin, o = lax.scan(step, s0, (qg, kg, u, wk, qk, g_last))
    o = o.transpose(1, 0, 3, 2, 4).reshape(B, L, H, -1)
    return o, s_fin


def _mixer(h, w_in, conv_w, dn_conv_w, a_log, dt_bias, dn_norm, w_out, s0_fwd, s0_bwd, on_grid):
    B, L, _ = h.shape
    f32 = jnp.float32
    proj = h @ w_in
    cb, cc, ch, qkv, z, ab = jnp.split(proj, SPLITS, axis=-1)
    u = cc * ch
    if on_grid:
        rows = L // GRID_W
        u = _conv3(u.reshape(B, rows, GRID_W, CONV_WIDTH), conv_w).reshape(B, L, CONV_WIDTH)
    else:
        u = _conv3(u, conv_w)
    y_conv = cb * u
    qkv = jax.nn.silu(_conv3(qkv, dn_conv_w))
    q, k, v = jnp.split(qkv, [DN_KEY, 2 * DN_KEY], axis=-1)
    q = _l2norm(q.astype(f32).reshape(B, L, DN_HEADS, DN_DK))
    k = _l2norm(k.astype(f32).reshape(B, L, DN_HEADS, DN_DK))
    v = v.astype(f32).reshape(B, L, DN_HEADS, DN_DV)
    ab = ab.astype(f32).reshape(B, L, 4, DN_HEADS)
    A = jnp.exp(a_log.astype(f32))
    dtb = dt_bias.astype(f32)
    g_f = -A[0] * jax.nn.softplus(ab[:, :, 0] + dtb[0])
    beta_f = jax.nn.sigmoid(ab[:, :, 1])
    g_b = -A[1] * jax.nn.softplus(ab[:, :, 2] + dtb[1])
    beta_b = jax.nn.sigmoid(ab[:, :, 3])
    o_f, s_f = _gated_delta(q, k, v, beta_f, g_f, s0_fwd.astype(f32))
    rev = lambda t: t[:, ::-1]
    o_b, s_b = _gated_delta(rev(q), rev(k), rev(v), rev(beta_b), rev(g_b), s0_bwd.astype(f32))
    o = o_f + rev(o_b)
    o = _rmsnorm(o, dn_norm) * jax.nn.silu(z.astype(f32)).reshape(B, L, DN_HEADS, DN_DV)
    y_dn = o.reshape(B, L, DN_VAL).astype(h.dtype)
    out = jnp.concatenate([y_conv, y_dn], axis=-1) @ w_out
    return out, s_f.astype(h.dtype), s_b.astype(h.dtype)


def _layer(x, mod, s0_fwd, s0_bwd, on_grid, norm_ffn1, w_ffn1_in, w_ffn1_out, norm_mix, w_mix_in, conv_w,
           dn_conv_w, dn_a_log, dn_dt_bias, dn_norm, w_mix_out, norm_ffn2, w_ffn2_in, w_ffn2_out):
    sh1, sc1, gt1, sh2, sc2, gt2, sh3, sc3, gt3 = jnp.split(mod, N_MOD, axis=-1)
    h = _rmsnorm(x, norm_ffn1) * (1 + sc1) + sh1
    x = x + 0.5 * gt1 * _swiglu(h, w_ffn1_in, w_ffn1_out)
    h = _rmsnorm(x, norm_mix) * (1 + sc2) + sh2
    m, s_f, s_b = _mixer(h, w_mix_in, conv_w, dn_conv_w, dn_a_log, dn_dt_bias, dn_norm, w_mix_out,
                         s0_fwd, s0_bwd, on_grid)
    x = x + gt2 * m
    h = _rmsnorm(x, norm_ffn2) * (1 + sc3) + sh3
    x = x + 0.5 * gt3 * _swiglu(h, w_ffn2_in, w_ffn2_out)
    return x, s_f, s_b


def setup_inputs(seed: int = 0) -> dict:
    key = jax.random.key(seed)
    ks = jax.random.split(key, 24)
    nrm = lambda k, shape, s: jax.random.normal(k, shape, jnp.float32) * s
    gain = lambda k, shape: 1.0 + 0.02 * jax.random.normal(k, shape, jnp.float32)
    dt = jnp.exp(jax.random.uniform(ks[15], (DEPTH, 2, DN_HEADS), jnp.float32,
                                    np.log(1e-3), np.log(1e-1)))
    return {
        "x_prompt": nrm(ks[0], (BATCH, SEQ, D_MODEL), 1.0),
        "x_sample": nrm(ks[1], (DEC_BATCH, DEC_SEQ, D_MODEL), 1.0),
        "state_dn_fwd": nrm(ks[2], (DEC_BATCH, DEPTH, DN_HEADS, DN_DK, DN_DV), 1.0),
        "state_dn_bwd": nrm(ks[3], (DEC_BATCH, DEPTH, DN_HEADS, DN_DK, DN_DV), 1.0),
        "c": nrm(ks[4], (DEC_BATCH, D_MODEL), 1.0),
        "c_ctx": nrm(ks[5], (D_MODEL,), 1.0),
        "w_ada": nrm(ks[6], (DEPTH, D_MODEL, N_MOD * D_MODEL), 0.5 * D_MODEL ** -0.5),
        "b_ada": nrm(ks[7], (DEPTH, N_MOD * D_MODEL), 0.02),
        "norm_ffn1": gain(ks[8], (DEPTH, D_MODEL)),
        "w_ffn1_in": nrm(ks[9], (DEPTH, D_MODEL, 2 * D_FF), D_MODEL ** -0.5),
        "w_ffn1_out": nrm(ks[10], (DEPTH, D_FF, D_MODEL), D_FF ** -0.5),
        "norm_mix": gain(ks[11], (DEPTH, D_MODEL)),
        "w_mix_in": nrm(ks[12], (DEPTH, D_MODEL, PROJ_DIM), D_MODEL ** -0.5),
        "conv_w": nrm(ks[13], (DEPTH, 3, CONV_WIDTH), 3 ** -0.5),
        "dn_conv_w": nrm(ks[14], (DEPTH, 3, 2 * DN_KEY + DN_VAL), 3 ** -0.5),
        "dn_a_log": jnp.log(jax.random.uniform(ks[16], (DEPTH, 2, DN_HEADS), jnp.float32, 1.0, 16.0)),
        "dn_dt_bias": dt + jnp.log(-jnp.expm1(-dt)),
        "dn_norm": gain(ks[17], (DEPTH, DN_DV)),
        "w_mix_out": nrm(ks[18], (DEPTH, CONV_WIDTH + DN_VAL, D_MODEL), (CONV_WIDTH + DN_VAL) ** -0.5),
        "norm_ffn2": gain(ks[19], (DEPTH, D_MODEL)),
        "w_ffn2_in": nrm(ks[20], (DEPTH, D_MODEL, 2 * D_FF), D_MODEL ** -0.5),
        "w_ffn2_out": nrm(ks[21], (DEPTH, D_FF, D_MODEL), D_FF ** -0.5),
        "norm_final": gain(ks[22], (D_MODEL,)),
    }


def reference(x_prompt, x_sample, state_dn_fwd, state_dn_bwd, c, c_ctx, w_ada, b_ada, norm_ffn1, w_ffn1_in,
              w_ffn1_out, norm_mix, w_mix_in, conv_w, dn_conv_w, dn_a_log, dn_dt_bias, dn_norm, w_mix_out,
              norm_ffn2, w_ffn2_in, w_ffn2_out, norm_final):
    xp, xs = x_prompt, x_sample
    nb = xp.shape[0]
    zero_state = jnp.zeros((nb, DN_HEADS, DN_DK, DN_DV), jnp.float32)
    new_f, new_b = [], []
    for l in range(DEPTH):
        lw = (norm_ffn1[l], w_ffn1_in[l], w_ffn1_out[l], norm_mix[l], w_mix_in[l], conv_w[l], dn_conv_w[l],
              dn_a_log[l], dn_dt_bias[l], dn_norm[l], w_mix_out[l], norm_ffn2[l], w_ffn2_in[l], w_ffn2_out[l])
        mod_ctx = (jax.nn.silu(c_ctx) @ w_ada[l] + b_ada[l])[None, None, :]
        mod_lat = (jax.nn.silu(c) @ w_ada[l] + b_ada[l])[:, None, :]
        xp, sf, sb = _layer(xp, mod_ctx, zero_state, zero_state, False, *lw)
        new_f.append(sf)
        new_b.append(sb)
        xs, _, _ = _layer(xs, mod_lat, state_dn_fwd[:, l], state_dn_bwd[:, l], True, *lw)
    y_prompt = _rmsnorm(xp, norm_final)
    y_sample = _rmsnorm(xs, norm_final)
    new_state_dn_fwd = jnp.stack(new_f, axis=1)
    new_state_dn_bwd = jnp.stack(new_b, axis=1)
    return (y_prompt, y_sample, new_state_dn_fwd, new_state_dn_bwd)
```

```cpp
#include <hip/hip_runtime.h>
#include <cstdio>
#include <cstdint>
#include <cmath>
namespace pg8 {
#define PG8_LAS __attribute__((address_space(3)))
typedef unsigned short bf16_t;
typedef short bf16x8 __attribute__((ext_vector_type(8)));
typedef float f32x4 __attribute__((ext_vector_type(4)));
typedef unsigned u32x4 __attribute__((ext_vector_type(4)));
constexpr int BM = 256, BK = 64, HALF = 128, HTB = HALF * BK * 2  , STAGE_BYTES = 8 * HTB, NXCD = 8, WGM = 8;

__host__ __device__ __forceinline__ int lds_byte(int r, int c) { const int st = (r >> 4) * 2 + (c >> 5), rr = r & 15, cc = c & 31, ob = rr * 64 + cc * 2; return st * 1024 + (ob ^ (((ob >> 9) & 1) << 5)); }
__host__ __device__ __forceinline__ void stage_rc(int b, int& R, int& C) { const int st = b / 1024, sb = b % 1024, swz = sb ^ (((sb >> 9) & 1) << 5); R = (st >> 1) * 16 + swz / 64; C = (st & 1) * 32 + (swz % 64) / 2; }
__host__ __device__ __forceinline__ int perm32(int rho) { const int n = rho >> 4, i = rho & 15; return 8 * (i >> 2) + 4 * n + (i & 3); }

struct Unit { int pm, pn; };
struct Gemm { const bf16_t* A; const bf16_t* Bt; int M, N, K; int lda; const bf16_t* A2; int ksplit; };

struct StaticOrder {
    int nM, nN, nwg, G, c;
    __host__ __device__ void init(int M, int N, int G_, int c_) { nM = M / BM; nN = N / BM; nwg = nM * nN; G = G_; c = c_; }
    __host__ __device__ bool next(int i, Unit& u) const {
        const long L = (long)i * G + c; if (L >= nwg) return false;
        int wgid = (int)L; { const int q = nwg / NXCD, r = nwg % NXCD, xcd = wgid % NXCD, off = wgid / NXCD; wgid = (xcd < r ? xcd * (q + 1) : r * (q + 1) + (xcd - r) * q) + off; }
        const int nig = WGM * nN, gid = wgid / nig, fm = gid * WGM, gsz = (nM - fm) < WGM ? (nM - fm) : WGM;
        u.pm = fm + ((wgid % nig) % gsz); u.pn = (wgid % nig) / gsz; return true;
    }
    __device__ __forceinline__ void a_ready(const Unit&) const {}
    __device__ __forceinline__ void done(const Unit&) const {}
};
struct SplitOrder : StaticOrder {
    int pm_off, wgm;
    __host__ __device__ void init(int M, int N, int G_, int c_, int M0, int G0) { const bool lo = c_ < G0; StaticOrder::init(lo ? M0 : M - M0, N, lo ? G0 : G_ - G0, lo ? c_ : c_ - G0); pm_off = lo ? 0 : M0 / BM;
        wgm = (G / NXCD) / nN; if (wgm < 1) wgm = 1; }
    __host__ __device__ bool next(int i, Unit& u) const {
        const long L = (long)i * G + c; if (L >= nwg) return false;
        int wgid = (int)L; { const int q = nwg / NXCD, r = nwg % NXCD, xcd = wgid % NXCD, off = wgid / NXCD; wgid = (xcd < r ? xcd * (q + 1) : r * (q + 1) + (xcd - r) * q) + off; }
        const int nig = wgm * nN, gid = wgid / nig, fm = gid * wgm, gsz = (nM - fm) < wgm ? (nM - fm) : wgm;
        u.pm = pm_off + fm + ((wgid % nig) % gsz); u.pn = (wgid % nig) / gsz; return true;
    }
};
struct TwoStageOrder : StaticOrder {
    int nM0, n0; const unsigned* ctr; unsigned need; mutable int seen;
    __host__ __device__ void init(int M, int N, int G_, int c_, int M0, const unsigned* ctr_, unsigned need_) { StaticOrder::init(M, N, G_, c_); nM0 = M0 / BM; n0 = nM0 * nN; ctr = ctr_; need = need_; seen = 0; }
    __host__ __device__ bool next(int i, Unit& u) const {
        const long L = (long)i * G + c; if (L >= nwg) return false;
        const bool late = L >= n0; int wgid = late ? (int)L - n0 : (int)L; const int nw = late ? nwg - n0 : n0, nMs = late ? nM - nM0 : nM0;
        { const int q = nw / NXCD, r = nw % NXCD, xcd = wgid % NXCD, off = wgid / NXCD; wgid = (xcd < r ? xcd * (q + 1) : r * (q + 1) + (xcd - r) * q) + off; }
        const int nig = WGM * nN, gid = wgid / nig, fm = gid * WGM, gsz = (nMs - fm) < WGM ? (nMs - fm) : WGM;
        u.pm = (late ? nM0 : 0) + fm + ((wgid % nig) % gsz); u.pn = (wgid % nig) / gsz; return true;
    }
    __device__ __forceinline__ void a_ready(const Unit& u) const {
        if (u.pm >= nM0 && !seen) { seen = 1;
            if (threadIdx.x < 64) { unsigned spins = 0;
                while ((unsigned)__builtin_amdgcn_readfirstlane(__hip_atomic_load(ctr, __ATOMIC_RELAXED, __HIP_MEMORY_SCOPE_AGENT)) < need) { __builtin_amdgcn_s_sleep(8); if (++spins > (1u << 22)) break; }
                __builtin_amdgcn_fence(__ATOMIC_ACQUIRE, "agent");
                asm volatile("s_waitcnt vmcnt(0)" ::: "memory"); }
            __builtin_amdgcn_s_barrier(); }
    }
};

__device__ __forceinline__ unsigned cvt_pk_bf16(float lo, float hi) { unsigned r; asm volatile("v_cvt_pk_bf16_f32 %0, %1, %2" : "=v"(r) : "v"(lo), "v"(hi)); return r; }
__device__ __forceinline__ float silu_f(float a) { return a * __builtin_amdgcn_rcpf(1.0f + __expf(-a)); }

__device__ __forceinline__ float swiglu2(float a, float b) { return (a * b) * __builtin_amdgcn_rcpf(1.0f + __builtin_amdgcn_exp2f(-a)); }
#ifndef KLOOP_REPS
#define KLOOP_REPS_ 1
#else
#define KLOOP_REPS_ KLOOP_REPS
#endif
struct EpiSwiglu {
    static constexpr int KREP = KLOOP_REPS_;
    static constexpr bool PERM = true, AFTER_DRAIN = false;
    bf16_t* O; int ldc;
    __device__ __forceinline__ void operator()(const f32x4 (&acc)[2][2][4][2], const Unit& u, int wr, int wc, int fr, int fq) const {
        const int row0 = u.pm * BM + wr * 64 + fr, col0 = u.pn * HALF + wc * 32 + 8 * fq;
#pragma unroll
        for (int ai = 0; ai < 2; ++ai)
#pragma unroll
            for (int m = 0; m < 4; ++m) { bf16_t* rowp = O + (size_t)(row0 + ai * HALF + m * 16) * ldc + col0;
                const f32x4 a0 = acc[ai][0][m][0], a1 = acc[ai][0][m][1], b0 = acc[ai][1][m][0], b1 = acc[ai][1][m][1];
                u32x4 w;
                w.x = cvt_pk_bf16(swiglu2(a0[0], b0[0]), swiglu2(a0[1], b0[1])); w.y = cvt_pk_bf16(swiglu2(a0[2], b0[2]), swiglu2(a0[3], b0[3]));
                w.z = cvt_pk_bf16(swiglu2(a1[0], b1[0]), swiglu2(a1[1], b1[1])); w.w = cvt_pk_bf16(swiglu2(a1[2], b1[2]), swiglu2(a1[3], b1[3]));
                *(u32x4*)rowp = w; }
    }
};

template <bool BB, bool OB>
struct EpiResid {
    static constexpr int KREP = 1;
    static constexpr bool PERM = true, AFTER_DRAIN = false;
    const void* base0; const void* base1; int split_row; void* out; int ldc; const float* gate; int mod_ld; float coef;
    __device__ __forceinline__ void operator()(const f32x4 (&acc)[2][2][4][2], const Unit& u, int wr, int wc, int fr, int fq) const {
        const int row0 = u.pm * BM + wr * 64 + fr, col0 = u.pn * BM + wc * 32 + 8 * fq;
        const int midx = u.pm < 16 ? 0 : 1 + ((u.pm - 16) >> 4);
        const float* gp = gate + (size_t)midx * mod_ld + col0;
        f32x4 gv[2][2];
#pragma unroll
        for (int bj = 0; bj < 2; ++bj)
#pragma unroll
            for (int n = 0; n < 2; ++n) gv[bj][n] = *(const f32x4*)(gp + bj * HALF + n * 4) * coef;
#pragma unroll
        for (int ai = 0; ai < 2; ++ai)
#pragma unroll
            for (int m = 0; m < 4; ++m) { const int r = row0 + ai * HALF + m * 16;
                const size_t boff = (r < split_row ? (size_t)r : (size_t)(r - split_row)) * ldc + col0, ooff = (size_t)r * ldc + col0;
                const void* bsel = r < split_row ? base0 : base1;
#pragma unroll
                for (int bj = 0; bj < 2; ++bj) { f32x4 b0, b1;
                    if (BB) { const u32x4 w = *(const u32x4*)((const bf16_t*)bsel + boff + bj * HALF);
                        b0 = (f32x4){__builtin_bit_cast(float, w.x << 16), __builtin_bit_cast(float, w.x & 0xffff0000u), __builtin_bit_cast(float, w.y << 16), __builtin_bit_cast(float, w.y & 0xffff0000u)};
                        b1 = (f32x4){__builtin_bit_cast(float, w.z << 16), __builtin_bit_cast(float, w.z & 0xffff0000u), __builtin_bit_cast(float, w.w << 16), __builtin_bit_cast(float, w.w & 0xffff0000u)}; }
                    else { const float* bp = (const float*)bsel + boff + bj * HALF; b0 = *(const f32x4*)bp; b1 = *(const f32x4*)(bp + 4); }
                    const f32x4 o0 = b0 + gv[bj][0] * acc[ai][bj][m][0], o1 = b1 + gv[bj][1] * acc[ai][bj][m][1];
                    if (OB) { u32x4 w; w.x = cvt_pk_bf16(o0[0], o0[1]); w.y = cvt_pk_bf16(o0[2], o0[3]); w.z = cvt_pk_bf16(o1[0], o1[1]); w.w = cvt_pk_bf16(o1[2], o1[3]);
                        *(u32x4*)((bf16_t*)out + ooff + bj * HALF) = w; }
                    else { float* op = (float*)out + ooff + bj * HALF; *(f32x4*)op = o0; *(f32x4*)(op + 4) = o1; } }
            }
    }
};

struct EpiMixIn {
    static constexpr int KREP = 1;
    static constexpr bool PERM = true, AFTER_DRAIN = false;
    bf16_t* CB; bf16_t* UC; bf16_t* QKV; bf16_t* SZ;
    __device__ __forceinline__ void operator()(const f32x4 (&acc)[2][2][4][2], const Unit& u, int wr, int wc, int fr, int fq) const {
        const int row0 = u.pm * BM + wr * 64 + fr, lc = wc * 32 + 8 * fq;
        if (u.pn >= 2 && u.pn < 6) {
            const int col0 = (u.pn - 2) * HALF + lc;
#pragma unroll
            for (int ai = 0; ai < 2; ++ai)
#pragma unroll
                for (int m = 0; m < 4; ++m) { bf16_t* rowp = UC + (size_t)(row0 + ai * HALF + m * 16) * 512 + col0;
                    const f32x4 a0 = acc[ai][0][m][0], a1 = acc[ai][0][m][1], b0 = acc[ai][1][m][0], b1 = acc[ai][1][m][1];
                    u32x4 w; w.x = cvt_pk_bf16(a0[0] * b0[0], a0[1] * b0[1]); w.y = cvt_pk_bf16(a0[2] * b0[2], a0[3] * b0[3]);
                    w.z = cvt_pk_bf16(a1[0] * b1[0], a1[1] * b1[1]); w.w = cvt_pk_bf16(a1[2] * b1[2], a1[3] * b1[3]);
                    *(u32x4*)rowp = w; }
        } else {
            bf16_t* base; int ld, col0; bool act = false;
            if (u.pn < 2) { base = CB; ld = 512; col0 = u.pn * BM + lc; }
            else if (u.pn < 12) { base = QKV; ld = 1536; col0 = (u.pn - 6) * BM + lc; }
            else { base = SZ; ld = 512; col0 = (u.pn - 12) * BM + lc; act = true; }
#pragma unroll
            for (int ai = 0; ai < 2; ++ai)
#pragma unroll
                for (int m = 0; m < 4; ++m) { bf16_t* rowp = base + (size_t)(row0 + ai * HALF + m * 16) * ld + col0;
#pragma unroll
                    for (int bj = 0; bj < 2; ++bj) { f32x4 v0 = acc[ai][bj][m][0], v1 = acc[ai][bj][m][1];
                        if (act) { v0 = (f32x4){silu_f(v0[0]), silu_f(v0[1]), silu_f(v0[2]), silu_f(v0[3])}; v1 = (f32x4){silu_f(v1[0]), silu_f(v1[1]), silu_f(v1[2]), silu_f(v1[3])}; }
                        u32x4 w; w.x = cvt_pk_bf16(v0[0], v0[1]); w.y = cvt_pk_bf16(v0[2], v0[3]); w.z = cvt_pk_bf16(v1[0], v1[1]); w.w = cvt_pk_bf16(v1[2], v1[3]);
                        *(u32x4*)(rowp + bj * HALF) = w; } }
        }
    }
};

typedef float f32x2 __attribute__((ext_vector_type(2)));
template <class Epi, class Sched, bool ALIGN_EPI = false, bool SP2 = false, bool SPLITA = false>
__device__ __forceinline__ void gemm_phase(PG8_LAS unsigned char* lds, const Gemm g, const Sched& S, const Epi& E) {
    const int tid = threadIdx.x, wid = __builtin_amdgcn_readfirstlane(tid >> 6), lane = tid & 63, wr = wid >> 2, wc = wid & 3, fr = lane & 15, fq = lane >> 4;
    const int K = g.K, nt = K / BK;
    unsigned voffA[2], voffB[2];
#pragma unroll
    for (int i = 0; i < 2; ++i) { int R, C; stage_rc(tid * 16 + i * 8192, R, C); const int Rb = Epi::PERM ? ((R & ~31) + perm32(R & 31)) : R;
        voffA[i] = (unsigned)(R * g.lda + C) * 2u; voffB[i] = (unsigned)(Rb * K + C) * 2u; }
    const size_t kstep = (size_t)(BK * 2);
    const size_t hstep = (size_t)HALF * K * 2;
    const size_t tstep = 2 * hstep;
    const size_t hstepA = (size_t)HALF * g.lda * 2, tstepA = 2 * hstepA;
    const int ksplit = g.ksplit;
    const unsigned ldsw = (unsigned)wid * 1024u;
    const int aoff = lds_byte(wr * 64 + fr, fq * 8), boff = lds_byte(wc * 32 + fr, fq * 8);
#define PG8_SA(b, h) (((b) * 2 + (h)) * HTB)
#define PG8_SB(b, h) ((4 + (b) * 2 + (h)) * HTB)
#define PG8_STAGE(bufoff, gbase, voff) do { _Pragma("unroll") for (int _i = 0; _i < 2; ++_i) \
        __builtin_amdgcn_global_load_lds((const unsigned*)((const char*)(gbase) + (voff)[_i]), (PG8_LAS unsigned*)(lds + (bufoff) + ldsw + _i * 8192), 16, 0, 0); } while (0)
#define PG8_LDA(dst, b, h) do { _Pragma("unroll") for (int m = 0; m < 4; ++m) _Pragma("unroll") for (int k = 0; k < 2; ++k) dst[m][k] = *(const PG8_LAS bf16x8*)(lds + PG8_SA(b, h) + aoff + m * 2048 + k * 1024); } while (0)
#define PG8_LDB(dst, b, h) do { _Pragma("unroll") for (int n = 0; n < 2; ++n) _Pragma("unroll") for (int k = 0; k < 2; ++k) dst[n][k] = *(const PG8_LAS bf16x8*)(lds + PG8_SB(b, h) + boff + n * 2048 + k * 1024); } while (0)
#define PG8_MMA(ai, bj, At, Bt) do { __builtin_amdgcn_s_setprio(1); _Pragma("unroll") for (int m = 0; m < 4; ++m) _Pragma("unroll") for (int n = 0; n < 2; ++n) _Pragma("unroll") for (int k = 0; k < 2; ++k) \
        acc[ai][bj][m][n] = __builtin_amdgcn_mfma_f32_16x16x32_bf16(Bt[n][k], At[m][k], acc[ai][bj][m][n], 0, 0, 0); __builtin_amdgcn_s_setprio(0); } while (0)
#define PG8_WAIT_V(n) asm volatile("s_waitcnt vmcnt(" #n ")" ::: "memory")
#define PG8_WAIT_L(n) asm volatile("s_waitcnt lgkmcnt(" #n ")" ::: "memory")
#define PG8_BAR __builtin_amdgcn_s_barrier()
#define PG8_SCHED __builtin_amdgcn_sched_barrier(0)
    Unit cur, nxt; int ui = 0;
    if (!S.next(0, cur)) return;
    f32x4 acc[2][2][4][2];
#pragma unroll
    for (int a = 0; a < 2; ++a)
#pragma unroll
        for (int b = 0; b < 2; ++b)
#pragma unroll
            for (int m = 0; m < 4; ++m)
#pragma unroll
                for (int n = 0; n < 2; ++n) acc[a][b][m][n] = (f32x4){0.f, 0.f, 0.f, 0.f};
    bf16x8 At[4][2], B0[2][2], B1[2][2];
    const char* cA = (const char*)g.A + (size_t)cur.pm * tstepA; const char* cA2 = (const char*)g.A2 + (size_t)cur.pm * tstepA; const char* cB = (const char*)g.Bt + (size_t)cur.pn * tstep;
    S.a_ready(cur);
    if constexpr (SP2) {
        PG8_STAGE(PG8_SB(0, 0), cB, voffB); PG8_STAGE(PG8_SB(0, 1), cB + hstep, voffB); PG8_STAGE(PG8_SA(0, 0), cA, voffA); PG8_STAGE(PG8_SA(0, 1), cA + hstepA, voffA);
        if (wr == 1) PG8_BAR;
        PG8_WAIT_V(2); PG8_BAR;
        PG8_STAGE(PG8_SB(1, 0), cB + kstep, voffB); PG8_STAGE(PG8_SA(1, 0), cA + kstep, voffA); PG8_STAGE(PG8_SB(1, 1), cB + hstep + kstep, voffB);
        PG8_WAIT_V(6); PG8_BAR;
    } else {
        PG8_STAGE(PG8_SB(0, 0), cB, voffB); PG8_STAGE(PG8_SA(0, 0), cA, voffA); PG8_STAGE(PG8_SB(0, 1), cB + hstep, voffB); PG8_STAGE(PG8_SA(0, 1), cA + hstepA, voffA);
        if (wr == 1) PG8_BAR;
        PG8_WAIT_V(4); PG8_BAR;
        PG8_STAGE(PG8_SB(1, 0), cB + kstep, voffB); PG8_STAGE(PG8_SA(1, 0), cA + kstep, voffA); PG8_STAGE(PG8_SB(1, 1), cB + hstep + kstep, voffB);
        PG8_WAIT_V(6); PG8_BAR;
    }
    for (;;) {
        const bool has_next = S.next(ui + 1, nxt);
        const char* nA = has_next ? (const char*)g.A + (size_t)nxt.pm * tstepA : cA; const char* nB = has_next ? (const char*)g.Bt + (size_t)nxt.pn * tstep : cB;
#ifdef KLOOP_REPS
        constexpr int KR = Epi::KREP;
#else
        constexpr int KR = 1;
#endif
        for (int tt = 0; tt < nt * KR; tt += 2) {
            const int t = KR > 1 ? tt % nt : tt;
            const bool last = (tt == nt * KR - 2);
            const int t2 = (KR > 1 && t + 2 >= nt) ? 0 : t + 2;
            const char* a1 = (SPLITA && t + 1 >= ksplit ? cA2 : cA) + (size_t)(t + 1) * kstep;
            const char* a2 = last ? nA : (SPLITA && t2 >= ksplit ? cA2 : cA) + (size_t)t2 * kstep; const char* b2 = last ? nB : cB + (size_t)t2 * kstep;
            const char* a3 = a2 + kstep; const char* b3 = b2 + kstep;
            if (last && has_next) S.a_ready(nxt);
            if constexpr (SP2) {
            PG8_LDB(B0, 0, 0); PG8_LDB(B1, 0, 1); PG8_SCHED; PG8_LDA(At, 0, 0); PG8_STAGE(PG8_SA(1, 1), a1 + hstepA, voffA);
            PG8_WAIT_V(8); PG8_WAIT_L(0); PG8_BAR; PG8_MMA(0, 0, At, B0); PG8_MMA(0, 1, At, B1); PG8_BAR; PG8_SCHED;
            PG8_LDA(At, 0, 1); PG8_STAGE(PG8_SB(0, 0), b2, voffB); PG8_STAGE(PG8_SB(0, 1), b2 + hstep, voffB); PG8_STAGE(PG8_SA(0, 0), a2, voffA);
            PG8_WAIT_V(8); PG8_WAIT_L(0); PG8_BAR; PG8_MMA(1, 0, At, B0); PG8_MMA(1, 1, At, B1); PG8_BAR; PG8_SCHED;
            PG8_LDB(B0, 1, 0); PG8_LDB(B1, 1, 1); PG8_SCHED; PG8_LDA(At, 1, 0); PG8_STAGE(PG8_SA(0, 1), a2 + hstepA, voffA);
            PG8_WAIT_V(8); PG8_WAIT_L(0); PG8_BAR; PG8_MMA(0, 0, At, B0); PG8_MMA(0, 1, At, B1); PG8_BAR; PG8_SCHED;
            PG8_LDA(At, 1, 1); PG8_STAGE(PG8_SB(1, 0), b3, voffB); PG8_STAGE(PG8_SB(1, 1), b3 + hstep, voffB); PG8_STAGE(PG8_SA(1, 0), a3, voffA);
            PG8_WAIT_V(8); PG8_WAIT_L(0); PG8_BAR; PG8_MMA(1, 0, At, B0); PG8_MMA(1, 1, At, B1); PG8_BAR; PG8_SCHED;
            } else {
            PG8_LDB(B0, 0, 0); PG8_SCHED; PG8_LDA(At, 0, 0); PG8_STAGE(PG8_SA(1, 1), a1 + hstepA, voffA);
            PG8_WAIT_L(8); PG8_BAR; PG8_WAIT_L(0); PG8_MMA(0, 0, At, B0); PG8_BAR; PG8_SCHED;
            PG8_LDB(B1, 0, 1); PG8_STAGE(PG8_SB(0, 0), b2, voffB);
            PG8_BAR; PG8_WAIT_L(0); PG8_MMA(0, 1, At, B1); PG8_BAR;
            PG8_LDA(At, 0, 1); PG8_STAGE(PG8_SA(0, 0), a2, voffA);
            PG8_BAR; PG8_WAIT_L(0); PG8_MMA(1, 0, At, B0); PG8_BAR; PG8_SCHED;
            PG8_STAGE(PG8_SB(0, 1), b2 + hstep, voffB);
            PG8_WAIT_V(6); PG8_BAR; PG8_MMA(1, 1, At, B1); PG8_BAR;
            PG8_LDB(B0, 1, 0); PG8_SCHED; PG8_LDA(At, 1, 0); PG8_STAGE(PG8_SA(0, 1), a2 + hstepA, voffA);
            PG8_WAIT_L(8); PG8_BAR; PG8_WAIT_L(0); PG8_MMA(0, 0, At, B0); PG8_BAR; PG8_SCHED;
            PG8_LDB(B1, 1, 1); PG8_STAGE(PG8_SB(1, 0), b3, voffB);
            PG8_BAR; PG8_WAIT_L(0); PG8_MMA(0, 1, At, B1); PG8_BAR;
            PG8_LDA(At, 1, 1); PG8_STAGE(PG8_SA(1, 0), a3, voffA);
            PG8_BAR; PG8_WAIT_L(0); PG8_MMA(1, 0, At, B0); PG8_BAR; PG8_SCHED;
            PG8_STAGE(PG8_SB(1, 1), b3 + hstep, voffB);
            PG8_WAIT_V(6); PG8_BAR; PG8_MMA(1, 1, At, B1); PG8_BAR;
            }
        }
        if constexpr (ALIGN_EPI) { if (wr == 0) PG8_BAR; }
        if constexpr (KR > 1) {
#pragma unroll
            for (int a = 0; a < 2; ++a)
#pragma unroll
                for (int b = 0; b < 2; ++b)
#pragma unroll
                    for (int m = 0; m < 4; ++m)
#pragma unroll
                        for (int n = 0; n < 2; ++n) acc[a][b][m][n] *= (1.0f / KR); }
        if constexpr (!Epi::AFTER_DRAIN) { E(acc, cur, wr, wc, fr, fq); S.done(cur); }
        if (!has_next) break;
#pragma unroll
        for (int a = 0; a < 2; ++a)
#pragma unroll
            for (int b = 0; b < 2; ++b)
#pragma unroll
                for (int m = 0; m < 4; ++m)
#pragma unroll
                    for (int n = 0; n < 2; ++n) { f32x2 lo, hi; asm volatile("v_mov_b64 %0, 0" : "=v"(lo)); asm volatile("v_mov_b64 %0, 0" : "=v"(hi)); acc[a][b][m][n] = (f32x4){lo.x, lo.y, hi.x, hi.y}; }
        cur = nxt; cA = nA; cA2 = (const char*)g.A2 + (size_t)cur.pm * tstepA; cB = nB; ++ui;
        if constexpr (ALIGN_EPI) { if (wr == 1) PG8_BAR; }
    }
    PG8_WAIT_V(0);
    if constexpr (!ALIGN_EPI) { if (wr == 0) PG8_BAR; }
    PG8_BAR;
    if constexpr (Epi::AFTER_DRAIN) { E.fused(acc, cur, wr, wc, fr, fq, lds, wid, lane); S.done(cur); }
#undef PG8_SA
#undef PG8_SB
#undef PG8_STAGE
#undef PG8_LDA
#undef PG8_LDB
#undef PG8_MMA
#undef PG8_WAIT_V
#undef PG8_WAIT_L
#undef PG8_BAR
#undef PG8_SCHED
}
}

constexpr int NWAVES = 8;
constexpr int D = 1024, TP = 4096, TS = 32768, T = TP + TS, FF = 2816, NFFI = 2 * FF, NMIX = 3584, PROJ = 3600;
constexpr int NB_P = 16, L_P = 256, NB_S = 8, L_S = 4096, NH = 4, DKV = 128, NMOD = 9 * D;
constexpr float EPS = 1e-6f;
#ifndef MK_N_LAUNCHES
#define MK_N_LAUNCHES 1
#endif
constexpr int N_PHASES = 14;
#ifndef PREP_PROBE_DM
#define PREP_PROBE_DM 3
#endif
#ifndef GEMM_SP2
#define GEMM_SP2 true
#endif
#ifndef RESID_ALIGN
#define RESID_ALIGN true
#endif
#ifndef NOSHADOW
#define NOSHADOW 0
#endif
#ifndef SWIGLU_ALIGN
#define SWIGLU_ALIGN true
#endif
#ifndef W2_IN_P0
#define W2_IN_P0 2
#endif
#ifndef CONV_IN_SCAN
#define CONV_IN_SCAN 1
#endif

constexpr size_t MiB = 1u << 20;
constexpr size_t WS_CTL = 0, CTL_ZERO_BYTES = 256 * 1024;
constexpr size_t WS_MOD = 1 * MiB;
constexpr size_t WS_GSC = 2 * MiB, GSC_STRIDE = (size_t)T * 4 * 4;
constexpr size_t WS_WF1I = 6 * MiB, WS_WF1O = 17 * MiB, WS_WMI = 23 * MiB, WS_WMO = 30 * MiB, WS_WF2I = 32 * MiB, WS_WF2O = 43 * MiB;
constexpr size_t WS_H = 50 * MiB;
constexpr size_t WS_ACT = 122 * MiB;
constexpr size_t WS_CB = 122 * MiB, WS_UC = 158 * MiB, WS_SZ = 194 * MiB, WS_QKV = 230 * MiB;
constexpr size_t WS_END = 512 * MiB;
constexpr int CW_BAR = 4096;
constexpr int CW_ADA_DONE = 384;
constexpr int CW_Q_CONV = 64, CW_Q_WT = 128, CW_Q_N2 = 192, CW_Q_N3 = 256, CW_Q_NF = 320;
constexpr int CW_TAIL2 = 448, CW_TAIL3 = 512;
constexpr int CW_EDONE = 640;
constexpr int CW_XPUB = 8192, CW_ECNT = 14336;
constexpr int CW_RDY = 32768, RDY_BANK = 160 * 64;
constexpr size_t WS_YC = 306 * MiB;
constexpr size_t WS_YD = 50 * MiB;
constexpr size_t WS_X2B = 420 * MiB;
constexpr size_t WS_H3 = 342 * MiB;
static_assert((CW_RDY + 3 * RDY_BANK) * 4 <= (int)CTL_ZERO_BYTES && (CW_BAR + 3456) * 4 <= (int)CTL_ZERO_BYTES, "control words inside the per-call memset");

constexpr int RING_OFF = 0, RING_BYTES = 131072;
constexpr int LDS_BYTES = 163840;
constexpr int LDSCTL_OFF = LDS_BYTES - 512, MISC_OFF = LDSCTL_OFF + 320;

#define GAS __attribute__((address_space(1)))
#define LAS __attribute__((address_space(3)))
typedef unsigned short bf16;
typedef unsigned v4u __attribute__((ext_vector_type(4)));
typedef unsigned v2u __attribute__((ext_vector_type(2)));
typedef float f32x4 __attribute__((ext_vector_type(4)));
typedef short bf16x8 __attribute__((ext_vector_type(8)));
typedef GAS unsigned gu32;
#define RLX_AGENT __ATOMIC_RELAXED, __HIP_MEMORY_SCOPE_AGENT
#define LDS_WAIT() asm volatile("s_waitcnt lgkmcnt(0)" ::: "memory")
#define VM_WAIT() asm volatile("s_waitcnt vmcnt(0)" ::: "memory")
__device__ __forceinline__ unsigned f2bf(float f) { unsigned u = __builtin_bit_cast(unsigned, f); return (u + 0x7fffu + ((u >> 16) & 1u)) >> 16; }
__device__ __forceinline__ unsigned pk2(float lo, float hi) { return f2bf(lo) | (f2bf(hi) << 16); }
__device__ __forceinline__ float bf2f(unsigned short u) { return __builtin_bit_cast(float, (unsigned)u << 16); }
__device__ __forceinline__ float bflo(unsigned w) { return __builtin_bit_cast(float, w << 16); }
__device__ __forceinline__ float bfhi(unsigned w) { return __builtin_bit_cast(float, w & 0xffff0000u); }
__device__ __forceinline__ float siluf(float a) { return a / (1.0f + __expf(-a)); }
#define XB_TMO      128
#define XB_XCNT(j)  (256  + 64 * (j))
#define XB_XSUB(j)  (1280 + 64 * (j))
#define XB_XGEN(j)  (2304 + 64 * (j))
#define XB_TOP      3328
#define XB_TOPGEN   3392
#define XCD_BAR_WORDS 3456
#define XB_SPIN_CAP (1u << 18)

__device__ __forceinline__ unsigned xb_ld(unsigned* p)              { return __hip_atomic_load(p, __ATOMIC_RELAXED, __HIP_MEMORY_SCOPE_AGENT); }
__device__ __forceinline__ unsigned xb_add(unsigned* p, unsigned v) { return __hip_atomic_fetch_add(p, v, __ATOMIC_RELAXED, __HIP_MEMORY_SCOPE_AGENT); }
__device__ __forceinline__ unsigned xb_xcc_id() { return (unsigned)__builtin_amdgcn_s_getreg((3 << 11) | 20) & 0xFu; }
#define XB_SPIN(cond, bar) do { unsigned _sp = 0; while (cond) { if (_sp < 8u) __builtin_amdgcn_s_sleep(1); else __builtin_amdgcn_s_sleep(32); \
    if ((++_sp & 255u) == 0u) { if (xb_ld(&(bar)[XB_TMO])) break; if (_sp > XB_SPIN_CAP) { atomicAdd(&(bar)[XB_TMO], 1u); break; } } } } while (0)

struct XcdBarrier {
    unsigned* bar; unsigned x;
    volatile LAS unsigned* st;
};

__device__ __forceinline__ XcdBarrier xcd_barrier_post(unsigned* bar, volatile LAS unsigned* st) {
    XcdBarrier b; b.bar = bar; b.x = xb_xcc_id(); b.st = st;
    if (threadIdx.x == 0) (void)xb_add(&bar[XB_XCNT(b.x)], 1u);
    return b;
}
__device__ __forceinline__ void xcd_barrier_complete(unsigned* bar, unsigned x, unsigned& nloc, unsigned& nx) {
    const unsigned G = gridDim.x * gridDim.y * gridDim.z;
    unsigned sum, cnt, mine, sp = 0u;
    for (;;) {
        sum = 0u; cnt = 0u; mine = 0u;
#pragma unroll
        for (unsigned j = 0; j < 16; ++j) { const unsigned c = xb_ld(&bar[XB_XCNT(j)]); sum += c; cnt += (c > 0u) ? 1u : 0u; mine = (j == x) ? c : mine; }
        if (sum == G) break;
        __builtin_amdgcn_s_sleep(1);
        if ((++sp & 255u) == 0u) { if (xb_ld(&bar[XB_TMO])) break; if (sp > XB_SPIN_CAP) { atomicAdd(&bar[XB_TMO], 1u); break; } }
    }
    nloc = mine > 0u ? mine : 1u; nx = cnt > 0u ? cnt : 1u;
}

__device__ __forceinline__ void xcd_barrier(const XcdBarrier& b) {
    asm volatile("s_waitcnt vmcnt(0)" ::: "memory");
    __syncthreads();
    if (threadIdx.x == 0) {
        unsigned* bar = b.bar;
        __builtin_amdgcn_s_waitcnt(0);
        unsigned nloc = b.st[0], nx = b.st[1];
        if (nloc == 0u) { xcd_barrier_complete(bar, b.x, nloc, nx); b.st[0] = nloc; b.st[1] = nx; }
        const unsigned old = xb_add(&bar[XB_XSUB(b.x)], 1u);
        const unsigned gen = old / nloc;
        if (old + 1u == (gen + 1u) * nloc) {
            __builtin_amdgcn_fence(__ATOMIC_RELEASE, "agent");
            asm volatile("s_waitcnt vmcnt(0)" ::: "memory");
            const unsigned og = xb_add(&bar[XB_TOP], 1u);
            const unsigned tg = og / nx;
            if (og + 1u == (tg + 1u) * nx) xb_add(&bar[XB_TOPGEN], 1u);
            else XB_SPIN(xb_ld(&bar[XB_TOPGEN]) == tg, bar);
            __builtin_amdgcn_fence(__ATOMIC_ACQUIRE, "agent");
            xb_add(&bar[XB_XGEN(b.x)], 1u);
            asm volatile("s_waitcnt vmcnt(0)" ::: "memory");
        } else {
            XB_SPIN(xb_ld(&bar[XB_XGEN(b.x)]) == gen, bar);
            __builtin_amdgcn_fence(__ATOMIC_ACQUIRE, "agent");
            asm volatile("s_waitcnt vmcnt(0)" ::: "memory");
        }
    }
    __syncthreads();
}

struct Frame {
    LAS unsigned char* lds;
    volatile LAS unsigned* MISC;
    gu32* ctl;
    int tid, lane, wave;
    int vcu, G;
    unsigned xcc;
    const float* const* in; float* out; unsigned char* ws;
};
enum { I_XP = 0, I_XS, I_SF, I_SB, I_C, I_CCTX, I_WADA, I_BADA, I_NF1, I_WF1I, I_WF1O, I_NMIX, I_WMI, I_CONVW, I_DNCONVW, I_ALOG, I_DTB, I_DNNORM, I_WMO, I_NF2, I_WF2I, I_WF2O, I_NFIN };

__device__ __forceinline__ float wave_sum(float v) {
#pragma unroll
    for (int o = 1; o < 64; o <<= 1) v += __shfl_xor(v, o);
    return v;
}

__device__ __forceinline__ void p0_transpose_item(const float* W, int K, int ldw, bf16* WT, int kb, int n0, int drow, LAS float* scr, int lane, float scale = 1.0f) {
    const int k0 = 64 * kb;
    f32x4 tv[8];
#pragma unroll
    for (int i = 0; i < 8; ++i) { const int kk = 8 * i + (lane >> 3); tv[i] = *(const f32x4*)(W + (size_t)(k0 + kk) * ldw + n0 + 4 * (lane & 7)) * scale; }
#pragma unroll
    for (int i = 0; i < 8; ++i) { const int kk = 8 * i + (lane >> 3); LAS float* d = scr + kk * 33 + 4 * (lane & 7); d[0] = tv[i].x; d[1] = tv[i].y; d[2] = tv[i].z; d[3] = tv[i].w; }
    LDS_WAIT(); asm volatile("" ::: "memory");
    const int c = lane & 7;
#pragma unroll
    for (int j = 0; j < 4; ++j) { const int n = (lane >> 3) + 8 * j; const LAS float* s = scr + (8 * c) * 33 + n;
        v4u o; o.x = pk2(s[0 * 33], s[1 * 33]); o.y = pk2(s[2 * 33], s[3 * 33]); o.z = pk2(s[4 * 33], s[5 * 33]); o.w = pk2(s[6 * 33], s[7 * 33]);
        *(GAS v4u*)(WT + (size_t)(drow + n) * K + k0 + 8 * c) = o; }
    LDS_WAIT(); asm volatile("" ::: "memory");
}
__device__ __forceinline__ int ffi_drow(int n0) { return n0 < FF ? 256 * (n0 >> 7) + (n0 & 127) : 256 * ((n0 - FF) >> 7) + 128 + ((n0 - FF) & 127); }
__device__ __forceinline__ float ffi_scale(int n0) { return n0 < FF ? 1.44269504088896341f : 0.693147180559945309f; }
__device__ __forceinline__ int mi_drow(int n0) {
    if (n0 < 512 || n0 >= 1536) return n0;
    if (n0 < 1024) { const int j = n0 - 512; return 512 + 256 * (j >> 7) + (j & 127); }
    const int j = n0 - 1024; return 512 + 256 * (j >> 7) + 128 + (j & 127);
}

__device__ __forceinline__ void p0_prologue(Frame& F) {
    if ((int)blockIdx.x < NMOD / 64) {
        LAS float* sc = (LAS float*)(F.lds);
        LAS float* red = (LAS float*)(F.lds + 49152);
        { float cv[18];
#pragma unroll
          for (int i = 0; i < 18; ++i) { const int idx = F.tid + i * (NWAVES * 64), r = idx >> 10, k = idx & 1023; cv[i] = r == 0 ? F.in[I_CCTX][k] : F.in[I_C][(r - 1) * D + k]; }
#pragma unroll
          for (int i = 0; i < 18; ++i) { const int idx = F.tid + i * (NWAVES * 64), r = idx >> 10, k = idx & 1023; sc[k * 12 + r] = siluf(cv[i]); } }
        __syncthreads();
        const int n0 = blockIdx.x * 64; const float* W = F.in[I_WADA];
        const int c4 = F.lane & 15, rs = F.lane >> 4;
        f32x4 acc4[9];
#pragma unroll
        for (int r = 0; r < 9; ++r) acc4[r] = (f32x4){0.f, 0.f, 0.f, 0.f};
        const int kbeg = F.wave * 128;
#pragma unroll 1
        for (int kb = kbeg; kb < kbeg + 128; kb += 32) {
            f32x4 wv[8];
#pragma unroll
            for (int i = 0; i < 8; ++i) wv[i] = *(const f32x4*)(W + (size_t)(kb + 4 * i + rs) * NMOD + n0 + 4 * c4);
#pragma unroll
            for (int i = 0; i < 8; ++i) { const LAS float* s = sc + (kb + 4 * i + rs) * 12;
                const f32x4 s0 = *(const LAS f32x4*)s, s1 = *(const LAS f32x4*)(s + 4); const float s8 = s[8];
                acc4[0] += s0.x * wv[i]; acc4[1] += s0.y * wv[i]; acc4[2] += s0.z * wv[i]; acc4[3] += s0.w * wv[i];
                acc4[4] += s1.x * wv[i]; acc4[5] += s1.y * wv[i]; acc4[6] += s1.z * wv[i]; acc4[7] += s1.w * wv[i]; acc4[8] += s8 * wv[i]; } }
#pragma unroll
        for (int r = 0; r < 9; ++r) {
#pragma unroll
            for (int t = 0; t < 4; ++t) { float v = acc4[r][t]; v += __shfl_xor(v, 16); v += __shfl_xor(v, 32); acc4[r][t] = v; }
            if (rs == 0) *(LAS f32x4*)(red + (F.wave * 9 + r) * 64 + 4 * c4) = acc4[r]; }
        __syncthreads();
        for (int idx = F.tid; idx < 9 * 64; idx += NWAVES * 64) { const int r = idx >> 6, c = idx & 63; float s = F.in[I_BADA][n0 + c];
#pragma unroll
            for (int w = 0; w < 8; ++w) s += red[(w * 9 + r) * 64 + c];
            ((float*)(F.ws + WS_MOD))[r * NMOD + n0 + c] = s; }
        __syncthreads();
    }
    LAS float* scr = (LAS float*)(F.lds + RING_OFF + F.wave * 16384);
    const int gw = F.vcu * NWAVES + F.wave, NGW = F.G * NWAVES;
    constexpr int I_FI = (D / 64) * (NFFI / 32), I_FO = (FF / 64) * (D / 32), I_MI = (D / 64) * (NMIX / 32), I_MO = (D / 64) * (D / 32);
#if W2_IN_P0 == 1
    constexpr int NITEMS = 2 * I_FI + 2 * I_FO + I_MI + I_MO;
#else
    constexpr int NITEMS = I_FI + I_FO + I_MI + I_MO;
#endif
    constexpr int N_ADA_BLK = NMOD / 64, NW_A = N_ADA_BLK * NWAVES, NW_B = (256 - N_ADA_BLK) * NWAVES;
    constexpr int NITEMS_B = (int)((long)NITEMS * (NW_B * 28) / (NW_B * 28 + NW_A * 15));
    const bool ada_blk = (int)blockIdx.x < N_ADA_BLK && F.G == 256;
    const int it0 = F.G != 256 ? gw : (ada_blk ? NITEMS_B + (int)blockIdx.x * NWAVES + F.wave : ((int)blockIdx.x - N_ADA_BLK) * NWAVES + F.wave);
    const int it_end = F.G != 256 ? NITEMS : (ada_blk ? NITEMS : NITEMS_B), it_step = F.G != 256 ? NGW : (ada_blk ? NW_A : NW_B);
    for (int it = it0; it < it_end; it += it_step) {
        int r = it;
        if (r < I_FI) { const int nb = r % (NFFI / 32), kb = r / (NFFI / 32); p0_transpose_item(F.in[I_WF1I], D, NFFI, (bf16*)(F.ws + WS_WF1I), kb, 32 * nb, ffi_drow(32 * nb), scr, F.lane, ffi_scale(32 * nb)); continue; } r -= I_FI;
        if (r < I_FO) { const int nb = r % (D / 32), kb = r / (D / 32); p0_transpose_item(F.in[I_WF1O], FF, D, (bf16*)(F.ws + WS_WF1O), kb, 32 * nb, 32 * nb, scr, F.lane); continue; } r -= I_FO;
        if (r < I_MI) { const int nb = r % (NMIX / 32), kb = r / (NMIX / 32); p0_transpose_item(F.in[I_WMI], D, PROJ, (bf16*)(F.ws + WS_WMI), kb, 32 * nb, mi_drow(32 * nb), scr, F.lane); continue; } r -= I_MI;
        if (r < I_MO) { const int nb = r % (D / 32), kb = r / (D / 32); p0_transpose_item(F.in[I_WMO], D, D, (bf16*)(F.ws + WS_WMO), kb, 32 * nb, 32 * nb, scr, F.lane); continue; } r -= I_MO;
        if (r < I_FI) { const int nb = r % (NFFI / 32), kb = r / (NFFI / 32); p0_transpose_item(F.in[I_WF2I], D, NFFI, (bf16*)(F.ws + WS_WF2I), kb, 32 * nb, ffi_drow(32 * nb), scr, F.lane, ffi_scale(32 * nb)); continue; } r -= I_FI;
        { const int nb = r % (D / 32), kb = r / (D / 32); p0_transpose_item(F.in[I_WF2O], FF, D, (bf16*)(F.ws + WS_WF2O), kb, 32 * nb, 32 * nb, scr, F.lane); }
    }
}
__device__ __forceinline__ void wait_ada(Frame& F) {
    unsigned spins = 0;
    while ((unsigned)__builtin_amdgcn_readfirstlane(__hip_atomic_load(F.ctl + CW_ADA_DONE, RLX_AGENT)) < (unsigned)(NMOD / 64)) { __builtin_amdgcn_s_sleep(8); if (++spins > (1u << 22)) break; }
    __builtin_amdgcn_fence(__ATOMIC_ACQUIRE, "agent");
    asm volatile("s_waitcnt vmcnt(0)" ::: "memory");
}
__device__ __forceinline__ int q_take(gu32* head, unsigned n, int lane) {
    unsigned v = 0; if (lane == 0) v = __hip_atomic_fetch_add(head, n, RLX_AGENT);
    return (int)__builtin_amdgcn_readfirstlane(v);
}
__device__ __forceinline__ void ffn2_weights_queue(Frame& F, LAS float* scr) {
    constexpr int I_FI = (D / 64) * (NFFI / 32), I_FO = (FF / 64) * (D / 32);
    for (;;) { int r = q_take(F.ctl + CW_Q_WT, 1u, F.lane); if (r >= I_FI + I_FO) break;
        if (r < I_FI) { const int nb = r % (NFFI / 32), kb = r / (NFFI / 32); p0_transpose_item(F.in[I_WF2I], D, NFFI, (bf16*)(F.ws + WS_WF2I), kb, 32 * nb, ffi_drow(32 * nb), scr, F.lane, ffi_scale(32 * nb)); }
        else { r -= I_FI; const int nb = r % (D / 32), kb = r / (D / 32); p0_transpose_item(F.in[I_WF2O], FF, D, (bf16*)(F.ws + WS_WF2O), kb, 32 * nb, 32 * nb, scr, F.lane); } }
}

__device__ __forceinline__ void ffn2_weights_static(Frame& F, LAS float* scr, int wi, int nw) {
    constexpr int I_FI = (D / 64) * (NFFI / 32), I_FO = (FF / 64) * (D / 32);
    for (int r = wi; r < I_FI + I_FO; r += nw) {
        if (r < I_FI) { const int nb = r % (NFFI / 32), kb = r / (NFFI / 32); p0_transpose_item(F.in[I_WF2I], D, NFFI, (bf16*)(F.ws + WS_WF2I), kb, 32 * nb, ffi_drow(32 * nb), scr, F.lane, ffi_scale(32 * nb)); }
        else { const int q = r - I_FI; const int nb = q % (D / 32), kb = q / (D / 32); p0_transpose_item(F.in[I_WF2O], FF, D, (bf16*)(F.ws + WS_WF2O), kb, 32 * nb, 32 * nb, scr, F.lane); } }
}

#define NIDX(lane, j) (8 * (lane) + 512 * ((j) >> 1) + 4 * ((j) & 1))
template <bool SB> struct RowBuf;
template <> struct RowBuf<true> { v4u w[2]; };
template <> struct RowBuf<false> { f32x4 w[4]; };
template <bool SB>
__device__ __forceinline__ void norm_fetch(RowBuf<SB>& b, int m, const void* src0, const void* src1, int lane) {
    if constexpr (SB) { const bf16* xr = m < TP ? (const bf16*)src0 + (size_t)m * D : (const bf16*)src1 + (size_t)(m - TP) * D;
#pragma unroll
        for (int j = 0; j < 2; ++j) b.w[j] = *(const v4u*)(xr + 8 * lane + 512 * j); }
    else { const float* xr = m < TP ? (const float*)src0 + (size_t)m * D : (const float*)src1 + (size_t)(m - TP) * D;
#pragma unroll
        for (int j = 0; j < 4; ++j) b.w[j] = *(const f32x4*)(xr + NIDX(lane, j)); }
}
template <int MODE, bool SB>
__device__ __forceinline__ void norm_row(Frame& F, int m, const RowBuf<SB>& rb, const f32x4 (&gv)[4], const float* mod, int off_shift, int off_scale, bf16* H, LAS float* wab) {
        f32x4 v[4]; float s = 0.f;
        if constexpr (SB) {
#pragma unroll
            for (int j = 0; j < 2; ++j) { const v4u w = rb.w[j]; v[2 * j] = (f32x4){bflo(w.x), bfhi(w.x), bflo(w.y), bfhi(w.y)}; v[2 * j + 1] = (f32x4){bflo(w.z), bfhi(w.z), bflo(w.w), bfhi(w.w)}; } }
        else {
#pragma unroll
            for (int j = 0; j < 4; ++j) v[j] = rb.w[j]; }
#pragma unroll
        for (int j = 0; j < 4; ++j) { s += (v[j].x * v[j].x + v[j].y * v[j].y) + (v[j].z * v[j].z + v[j].w * v[j].w); }
        const float rstd = 1.0f / sqrtf(wave_sum(s) * (1.f / D) + EPS);
        if (MODE == 2) {
            float* o = F.out + (size_t)m * D;
#pragma unroll
            for (int j = 0; j < 4; ++j) *(f32x4*)(o + NIDX(F.lane, j)) = v[j] * rstd * gv[j];
        } else {
            const int midx = m < TP ? 0 : 1 + ((m - TP) >> 12);
            const float* mrow = mod + (size_t)midx * NMOD;
#pragma unroll
            for (int j = 0; j < 4; ++j) { const f32x4 sh = *(const f32x4*)(mrow + off_shift + NIDX(F.lane, j)), sc = *(const f32x4*)(mrow + off_scale + NIDX(F.lane, j));
                v[j] = v[j] * rstd * gv[j] * (sc + 1.0f) + sh; }
#pragma unroll
            for (int jp = 0; jp < 2; ++jp) { v4u w; w.x = pk2(v[2 * jp].x, v[2 * jp].y); w.y = pk2(v[2 * jp].z, v[2 * jp].w); w.z = pk2(v[2 * jp + 1].x, v[2 * jp + 1].y); w.w = pk2(v[2 * jp + 1].z, v[2 * jp + 1].w);
                *(v4u*)(H + (size_t)m * D + 8 * F.lane + 512 * jp) = w; }
            if (MODE == 1) {
                float acc[16];
#pragma unroll
                for (int o = 0; o < 16; ++o) acc[o] = 0.f;
                int fence = 0;
#pragma unroll
                for (int j = 0; j < 4; ++j) {
                    asm volatile("" : "+v"(fence), "+v"(acc[0]));
#pragma unroll
                    for (int o = 0; o < 16; ++o) { const f32x4 w = *(const LAS f32x4*)(wab + o * 1024 + 4 * F.lane + 256 * j + fence); acc[o] += (v[j].x * w.x + v[j].y * w.y) + (v[j].z * w.z + v[j].w * w.w); } }
                const bool b5 = F.lane & 32, b4 = F.lane & 16, b3 = F.lane & 8, b2 = F.lane & 4;
                float r8[8], r4[4], r2[2];
#pragma unroll
                for (int o = 0; o < 8; ++o) { const float mine = b5 ? acc[o + 8] : acc[o], oth = b5 ? acc[o] : acc[o + 8]; r8[o] = mine + __shfl_xor(oth, 32); }
#pragma unroll
                for (int o = 0; o < 4; ++o) { const float mine = b4 ? r8[o + 4] : r8[o], oth = b4 ? r8[o] : r8[o + 4]; r4[o] = mine + __shfl_xor(oth, 16); }
#pragma unroll
                for (int o = 0; o < 2; ++o) { const float mine = b3 ? r4[o + 2] : r4[o], oth = b3 ? r4[o] : r4[o + 2]; r2[o] = mine + __shfl_xor(oth, 8); }
                float r1 = (b2 ? r2[1] : r2[0]) + __shfl_xor(b2 ? r2[0] : r2[1], 4);
                r1 += __shfl_xor(r1, 2); r1 += __shfl_xor(r1, 1);
                float abq[4];
#pragma unroll
                for (int q = 0; q < 4; ++q) abq[q] = __shfl(r1, (F.lane & 12) | (q << 4));
                if ((F.lane & 0x33) == 0) { const int h = F.lane >> 2;
                    const float af = abq[0], bfv = abq[1], abk = abq[2], bb = abq[3];
                    const float* alog = F.in[I_ALOG]; const float* dtb = F.in[I_DTB];
                    const float xf = af + dtb[h], xb = abk + dtb[4 + h];
                    const float spf = xf > 20.f ? xf : log1pf(expf(xf)), spb = xb > 20.f ? xb : log1pf(expf(xb));
                    float* gsc = (float*)(F.ws + WS_GSC);
                    gsc[(size_t)m * 4 + h] = -expf(alog[h]) * spf;
                    gsc[(size_t)T * 4 + (size_t)m * 4 + h] = 1.0f / (1.0f + expf(-bfv));
                    gsc[(size_t)2 * T * 4 + (size_t)m * 4 + h] = -expf(alog[4 + h]) * spb;
                    gsc[(size_t)3 * T * 4 + (size_t)m * 4 + h] = 1.0f / (1.0f + expf(-bb));
                }
            }
        }
}
template <int MODE>
__device__ __forceinline__ void norm_setup(Frame& F, LAS float* wab) {
    if (MODE == 1) {
        const float* W = F.in[I_WMI];
        float t[32];
#pragma unroll
        for (int i = 0; i < 32; ++i) { const int idx = F.tid + i * (NWAVES * 64); t[i] = W[(size_t)(idx >> 4) * PROJ + NMIX + (idx & 15)]; }
#pragma unroll
        for (int i = 0; i < 32; ++i) { const int idx = F.tid + i * (NWAVES * 64), k = idx >> 4;
            wab[(idx & 15) * 1024 + 4 * ((k & 511) >> 3) + 256 * (2 * (k >> 9) + ((k >> 2) & 1)) + (k & 3)] = t[i]; }
        __syncthreads();
    }
}
template <int MODE>
__device__ __forceinline__ void norm_phase(Frame& F, const float* src0, const float* src1, const float* gnorm, int off_shift, int off_scale, bf16* H) {
    const int gw = F.vcu * NWAVES + F.wave, NGW = F.G * NWAVES;
    LAS float* wab = (LAS float*)F.lds;
    norm_setup<MODE>(F, wab);
    const float* mod = (const float*)(F.ws + WS_MOD);
    f32x4 gv[4];
#pragma unroll
    for (int j = 0; j < 4; ++j) gv[j] = *(const f32x4*)(gnorm + NIDX(F.lane, j));
    RowBuf<false> cur, nxt;
    if (gw < T) norm_fetch<false>(cur, gw, src0, src1, F.lane);
#pragma unroll 1
    for (int m = gw; m < T; m += NGW) { const bool more = m + NGW < T; if (more) norm_fetch<false>(nxt, m + NGW, src0, src1, F.lane);
        norm_row<MODE, false>(F, m, cur, gv, mod, off_shift, off_scale, H, wab); if (more) cur = nxt; }
}
template <class Order>
__device__ __forceinline__ void publish_units(Frame& F, const Order& S, gu32* ready) {
    if (F.tid == 0) {
        __builtin_amdgcn_fence(__ATOMIC_RELEASE, "agent");
        asm volatile("s_waitcnt vmcnt(0)" ::: "memory");
        pg8::Unit u; for (int i = 0; S.next(i, u); ++i) __hip_atomic_fetch_add(ready + 64 * u.pm, 1u, RLX_AGENT);
    }
}
template <int MODE, bool SB>
__device__ __forceinline__ void norm_rows(Frame& F, const void* src0, const void* src1, const float* gnorm, int off_shift, int off_scale, bf16* H, int m0, int m1, int wi, int nw, int rows_per_wave, gu32* ready, bool setup = true) {
    LAS float* wab = (LAS float*)F.lds;
    if (setup) norm_setup<MODE>(F, wab);
    if (wi < 0) return;
    const float* mod = (const float*)(F.ws + WS_MOD);
    f32x4 gv[4];
#pragma unroll
    for (int j = 0; j < 4; ++j) gv[j] = *(const f32x4*)(gnorm + NIDX(F.lane, j));
    (void)ready;
    const int step = nw * rows_per_wave;
    int mb = m0 + wi * rows_per_wave, m = mb;
    RowBuf<SB> cur, nxt;
    if (m < m1) norm_fetch<SB>(cur, m, src0, src1, F.lane);
#pragma unroll 1
    while (m < m1) {
        int m2 = m + 1, mb2 = mb; if (m2 >= mb + rows_per_wave || m2 >= m1) { mb2 = mb + step; m2 = mb2; }
        const bool more = m2 < m1; if (more) norm_fetch<SB>(nxt, m2, src0, src1, F.lane);
        norm_row<MODE, SB>(F, m, cur, gv, mod, off_shift, off_scale, H, wab);
        if (more) cur = nxt;
        m = m2; mb = mb2;
    }
}
__device__ __forceinline__ void tail_publish(Frame& F, gu32* ctr) {
    asm volatile("s_waitcnt vmcnt(0)" ::: "memory");
    __syncthreads();
    if (F.tid == 0) { __builtin_amdgcn_fence(__ATOMIC_RELEASE, "agent"); asm volatile("s_waitcnt vmcnt(0)" ::: "memory"); __hip_atomic_fetch_add(ctr, 1u, RLX_AGENT); }
}
__device__ __forceinline__ void panel_wait(Frame& F, gu32* rp, unsigned need) {
    if (F.wave == 0) { unsigned spins = 0;
        while ((unsigned)__builtin_amdgcn_readfirstlane(__hip_atomic_load(rp, RLX_AGENT)) < need) { __builtin_amdgcn_s_sleep(8); if (++spins > (1u << 22)) break; }
        __builtin_amdgcn_fence(__ATOMIC_ACQUIRE, "agent");
        asm volatile("s_waitcnt vmcnt(0)" ::: "memory"); }
    __syncthreads();
}
__device__ __forceinline__ void xcd_publish(Frame& F, gu32* xsub, unsigned expected_local, gu32* gctr) {
    asm volatile("s_waitcnt vmcnt(0)" ::: "memory");
    __syncthreads();
    if (F.tid == 0) {
        const unsigned old = __hip_atomic_fetch_add(xsub + 64 * F.xcc, 1u, RLX_AGENT);
        if (old + 1u == expected_local) { __builtin_amdgcn_fence(__ATOMIC_RELEASE, "agent"); asm volatile("s_waitcnt vmcnt(0)" ::: "memory"); __hip_atomic_fetch_add(gctr, expected_local, RLX_AGENT); }
    }
}

typedef float f32x16 __attribute__((ext_vector_type(16)));
typedef __bf16 bf16x2_t __attribute__((ext_vector_type(2)));
typedef float f32x2_t __attribute__((ext_vector_type(2)));
#define MFMA32(a, b, c) __builtin_amdgcn_mfma_f32_32x32x16_bf16((a), (b), (c), 0, 0, 0)
__device__ __forceinline__ unsigned pkc(float lo, float hi) { f32x2_t v = {lo, hi}; bf16x2_t b = __builtin_convertvector(v, bf16x2_t); return __builtin_bit_cast(unsigned, b); }
__device__ __forceinline__ float rdlane(float v, int l) { return __builtin_bit_cast(float, __builtin_amdgcn_readlane(__builtin_bit_cast(int, v), l)); }
__device__ __forceinline__ float silu_fast(float a) { return a * __builtin_amdgcn_rcpf(1.0f + __expf(-a)); }
__device__ __forceinline__ int opaque(int x) { asm volatile("" : "+v"(x)); return x; }
__device__ __forceinline__ float opaquef(float x) { asm volatile("" : "+v"(x)); return x; }
__device__ __forceinline__ int crow(int r, int hh) { return (r & 3) + 8 * (r >> 2) + 4 * hh; }

constexpr int NCHUNK = T / 64;
constexpr size_t WS_QA = 342 * MiB, WS_KA = 378 * MiB, WS_KTA = 414 * MiB, WS_VACC = 450 * MiB;
constexpr size_t WS_TAF = 486 * MiB, WS_SC = 504 * MiB;
constexpr size_t WS_TAB = 50 * MiB, WS_QKAF = 68 * MiB, WS_QKAB = 86 * MiB;
__device__ __forceinline__ size_t o_off(int dir, int g) { return (g < TP / 64 ? (104 + 4 * (size_t)dir) * MiB : (238 + 32 * (size_t)dir) * MiB) + (size_t)g * 65536; }
static_assert(WS_SC + (size_t)NCHUNK * NH * 384 * 4 <= WS_END, "DN scalars vs workspace end");

__device__ __forceinline__ void store_rows_as_afrags(const float (&M)[64], bf16* dst, int lane) {
#pragma unroll
    for (int ks = 0; ks < 4; ++ks) {
        unsigned pa[4], pb[4];
        pa[0] = pkc(M[16 * ks + 0], M[16 * ks + 1]); pa[1] = pkc(M[16 * ks + 2], M[16 * ks + 3]); pa[2] = pkc(M[16 * ks + 8], M[16 * ks + 9]); pa[3] = pkc(M[16 * ks + 10], M[16 * ks + 11]);
        pb[0] = pkc(M[16 * ks + 4], M[16 * ks + 5]); pb[1] = pkc(M[16 * ks + 6], M[16 * ks + 7]); pb[2] = pkc(M[16 * ks + 12], M[16 * ks + 13]); pb[3] = pkc(M[16 * ks + 14], M[16 * ks + 15]);
#pragma unroll
        for (int q = 0; q < 4; ++q) { const auto r = __builtin_amdgcn_permlane32_swap(pa[q], pb[q], false, false); pa[q] = r[0]; pb[q] = r[1]; }
        v4u fa = {pa[0], pa[1], pa[2], pa[3]}, fb = {pb[0], pb[1], pb[2], pb[3]};
        *(v4u*)((char*)dst + (unsigned)lane * 16u + ks * 1024) = fa;
        *(v4u*)((char*)dst + 4096 + (unsigned)lane * 16u + ks * 1024) = fb;
        __builtin_amdgcn_sched_barrier(0);
    }
}

__device__ __forceinline__ void conv4(const v2u x0, const v2u x1, const v2u x2, const f32x4 w0, const f32x4 w1, const f32x4 w2, float (&o)[4]) {
    o[0] = silu_fast(w0.x * bflo(x0.x) + w1.x * bflo(x1.x) + w2.x * bflo(x2.x));
    o[1] = silu_fast(w0.y * bfhi(x0.x) + w1.y * bfhi(x1.x) + w2.y * bfhi(x2.x));
    o[2] = silu_fast(w0.z * bflo(x0.y) + w1.z * bflo(x1.y) + w2.z * bflo(x2.y));
    o[3] = silu_fast(w0.w * bfhi(x0.y) + w1.w * bfhi(x1.y) + w2.w * bfhi(x2.y));
}
__device__ __forceinline__ void stage_raw_tile(const bf16* raw, const float* cw, LAS unsigned char* sl, int m0, int p0, int L, int tok0, int colbase, int lane) {
        v4u st[9];
#pragma unroll
        for (int i = 0; i < 9; ++i) { const int pidx = lane + 64 * i, row = pidx >> 4, c16 = pidx & 15, t = tok0 - 1 + row;
            const bool ok = pidx < 544 && p0 + t >= 0 && p0 + t < L;
            st[i] = ok ? *(const v4u*)((const char*)raw + ((size_t)(m0 + t) * 1536 + colbase) * 2 + c16 * 16) : (v4u){0u, 0u, 0u, 0u}; }
        float wt[6];
#pragma unroll
        for (int i = 0; i < 6; ++i) { const int idx = lane + 64 * i; wt[i] = cw[(idx >> 7) * 1536 + colbase + (idx & 127)]; }
#pragma unroll
        for (int i = 0; i < 9; ++i) { const int pidx = lane + 64 * i, row = pidx >> 4, c16 = pidx & 15;
            if (pidx < 544) { LAS v2u* d = (LAS v2u*)(sl + row * 264 + c16 * 16); d[0] = (v2u){st[i].x, st[i].y}; d[1] = (v2u){st[i].z, st[i].w}; } }
#pragma unroll
        for (int i = 0; i < 6; ++i) ((LAS float*)(sl + 8976))[lane + 64 * i] = wt[i];
    }
__device__ __forceinline__ void load_norm_tile(const bf16* raw, const float* cw, LAS unsigned char* sl, int m0, int p0, int L, int tok0, int colbase, int lane, float scale, bf16x8 (&frag)[8]) {
    const int r32 = lane & 31, hh = lane >> 5;
    stage_raw_tile(raw, cw, sl, m0, p0, L, tok0, colbase, lane);
    float f[8][8]; float ss = 0.f;
    const LAS unsigned char* rp = sl + r32 * 264 + 8 * hh;
    const LAS float* wp = (const LAS float*)(sl + 8976) + 4 * hh;
    int fence = 0;
#pragma unroll
    for (int ks = 0; ks < 8; ++ks) {
        asm volatile("" : "+v"(fence), "+v"(ss));
#pragma unroll
        for (int pc = 0; pc < 2; ++pc) { const int cb = 32 * ks + 16 * pc;
            const v2u x0 = *(const LAS v2u*)(rp + cb + fence), x1 = *(const LAS v2u*)(rp + 264 + cb + fence), x2 = *(const LAS v2u*)(rp + 528 + cb + fence);
            const f32x4 w0 = *(const LAS f32x4*)(wp + cb / 2), w1 = *(const LAS f32x4*)(wp + 128 + cb / 2), w2 = *(const LAS f32x4*)(wp + 256 + cb / 2);
            float o[4]; conv4(x0, x1, x2, w0, w1, w2, o);
#pragma unroll
            for (int e = 0; e < 4; ++e) { f[ks][4 * pc + e] = o[e]; ss += o[e] * o[e]; } }
    }
    ss += __shfl_xor(ss, 32);
    const float rn = scale * __builtin_amdgcn_rsqf(ss + EPS);
#pragma unroll
    for (int ks = 0; ks < 8; ++ks) { v4u p; p.x = pkc(f[ks][0] * rn, f[ks][1] * rn); p.y = pkc(f[ks][2] * rn, f[ks][3] * rn); p.z = pkc(f[ks][4] * rn, f[ks][5] * rn); p.w = pkc(f[ks][6] * rn, f[ks][7] * rn);
        frag[ks] = __builtin_bit_cast(bf16x8, p); }
}

template <int J, int C0, bool FAKE>
__device__ __forceinline__ void subst_chunk(float (&M)[64], float negl, int lo, int hi) {
    float t[8];
#pragma unroll
    for (int e = 0; e < 8; ++e) if (C0 + e >= lo && C0 + e <= hi) t[e] = FAKE ? M[C0 + e] * 0.5f : rdlane(M[C0 + e], J);
    __builtin_amdgcn_sched_barrier(0);
#pragma unroll
    for (int e = 0; e < 8; ++e) if (C0 + e >= lo && C0 + e <= hi) M[C0 + e] = fmaf(negl, t[e], M[C0 + e]);
    __builtin_amdgcn_sched_barrier(0);
}
template <int J, int LO, int HI, bool FAKE, int C0 = 0>
__device__ __forceinline__ void subst_row(float (&M)[64], float negl) {
    if constexpr (C0 < 64) { if constexpr (C0 + 7 >= LO && C0 <= HI) subst_chunk<J, C0, FAKE>(M, negl, LO, HI); subst_row<J, LO, HI, FAKE, C0 + 8>(M, negl); }
}
template <bool FAKE, int J = 0>
__device__ __forceinline__ void subst_fwd(float (&M)[64], const float (&L)[64], int lane) {
    if constexpr (J < 63) { M[J] = lane == J ? 1.f : 0.f; subst_row<J, 0, J, FAKE>(M, -L[J]); subst_fwd<FAKE, J + 1>(M, L, lane); }
}
template <bool FAKE, int J = 63>
__device__ __forceinline__ void subst_bwd(float (&M)[64], const LAS float* stash, float bbw, float gcb, int lane) {
    if constexpr (J > 0) { const float lbv = bbw * stash[J * 64] * __expf(fminf(gcb - rdlane(gcb, J), 0.f)); const float lb = lane < J ? lbv : 0.f; M[J] = lane == J ? 1.f : 0.f;
        subst_row<J, J, 63, FAKE>(M, -lb); subst_bwd<FAKE, J - 1>(M, stash, bbw, gcb, lane); }
}

template <int DM>
__device__ __forceinline__ void prep_v_images(Frame& F, const bf16* raw, const float* cw, int m0, int p0, int L, int h, size_t gh, int lane) {
    if constexpr (!(DM & 4)) {
        bf16* VA = (bf16*)(F.ws + WS_VACC) + gh * 8192;
        LAS unsigned char* sl = F.lds + F.wave * 16384;
#pragma unroll 1
        for (int I = 0; I < 2; ++I) {
            stage_raw_tile(raw, cw, sl, m0, p0, L, 32 * I, 1024 + 128 * h, lane);
            asm volatile("s_waitcnt lgkmcnt(0)" ::: "memory");
#pragma unroll 1
            for (int pass = 0; pass < 2; ++pass) { const int d = 64 * pass + lane;
                const LAS float* wp = (const LAS float*)(sl + 8976) + d;
                const float w0 = wp[0], w1 = wp[128], w2 = wp[256];
                const LAS unsigned short* cp = (const LAS unsigned short*)sl + d;
                float xm = bf2f(cp[0]), xc = bf2f(cp[132]);
                float vv[32];
#pragma unroll
                for (int t = 0; t < 32; ++t) { const float xn = bf2f(cp[132 * (t + 2)]); vv[t] = silu_fast(w0 * xm + w1 * xc + w2 * xn); xm = xc; xc = xn; }
#pragma unroll
                for (int hp = 0; hp < 2; ++hp) { unsigned pk[8];
#pragma unroll
                    for (int q = 0; q < 8; ++q) { const int r0 = 2 * q, r1 = 2 * q + 1; pk[q] = pkc(vv[(r0 & 3) + 8 * (r0 >> 2) + 4 * hp], vv[(r1 & 3) + 8 * (r1 >> 2) + 4 * hp]); }
                    bf16* dst = VA + (size_t)((d >> 5) * 2 + I) * 1024 + ((d & 31) + 32 * hp) * 8;
                    *(v4u*)dst = (v4u){pk[0], pk[1], pk[2], pk[3]}; *(v4u*)(dst + 512) = (v4u){pk[4], pk[5], pk[6], pk[7]}; }
            }
            asm volatile("s_waitcnt lgkmcnt(0)" ::: "memory");
        }
    }
}

template <int DM>
__device__ __forceinline__ void dn_prep_item(Frame& F, int item) {
    const int g = item >> 2, h = item & 3, lane = opaque(F.lane), r32 = lane & 31, hh = lane >> 5;
    const int m0 = 64 * g;
    int L, p0; if (m0 < TP) { L = L_P; p0 = m0 & (L_P - 1); } else { L = L_S; p0 = (m0 - TP) & (L_S - 1); }
    const bf16* raw = (const bf16*)(F.ws + WS_QKV);
    const float* cw = F.in[I_DNCONVW];
    const size_t gh = (size_t)g * NH + h;
    bf16* KA = (bf16*)(F.ws + WS_KA) + gh * 8192; bf16* QA = (bf16*)(F.ws + WS_QA) + gh * 8192; bf16* KTA = (bf16*)(F.ws + WS_KTA) + gh * 8192;
    const bool v_first = !(F.wave & 1);
    if (v_first) prep_v_images<DM>(F, raw, cw, m0, p0, L, h, gh, lane);
    bf16x8 kf[2][8];
    LAS unsigned char* sl = F.lds + F.wave * 16384;
#pragma unroll
    for (int I = 0; I < 2; ++I) { const int tok = 32 * I + r32;
        load_norm_tile(raw, cw, sl, m0, p0, L, 32 * I, 512 + 128 * h, lane, 1.0f, kf[I]);
        { char* kab = (char*)KA + (size_t)I * 8192; const unsigned lo16 = (unsigned)lane * 16u;
#pragma unroll
          for (int ks = 0; ks < 8; ++ks) *(bf16x8*)(kab + lo16 + ks * 1024) = kf[I][ks]; }
        if constexpr (!(DM & 8)) { const int x = tok & 15, hp = (x >> 2) & 1, jp = 4 * (x >> 3) + (x & 3), kl = (tok >> 4) & 1;
          LAS unsigned char* img = sl + (unsigned)(((kl * 64 + 4 * hh + 32 * hp) * 8 + jp) * 2);
#pragma unroll
          for (int ks = 0; ks < 8; ++ks) {
#pragma unroll
            for (int j = 0; j < 8; ++j) *(LAS unsigned short*)(img + (ks >> 1) * 2048 + (16 * (ks & 1) + 8 * (j >> 2) + (j & 3)) * 16) = (unsigned short)kf[I][ks][j]; }
          v4u pc[8];
#pragma unroll
          for (int i = 0; i < 8; ++i) pc[i] = *(const LAS v4u*)(sl + i * 1024 + lane * 16);
#pragma unroll
          for (int i = 0; i < 8; ++i) *(v4u*)((char*)KTA + (size_t)(((i >> 1) * 4 + 2 * I + (i & 1)) * 1024) + lane * 16) = pc[i];
          __builtin_amdgcn_sched_barrier(0); }

    }
    const float* gsc = (const float*)(F.ws + WS_GSC);
    const size_t mrow = (size_t)(m0 + lane) * 4 + h;
    const float gf = gsc[mrow], bfw = gsc[(size_t)T * 4 + mrow], gb = gsc[(size_t)2 * T * 4 + mrow], bbw = gsc[(size_t)3 * T * 4 + mrow];
    float gcf = gf, pb = gb;
#pragma unroll
    for (int o = 1; o < 64; o <<= 1) { const float y = __shfl_up(gcf, o), y2 = __shfl_up(pb, o); if (lane >= o) { gcf += y; pb += y2; } }
    const float gcb = rdlane(pb, 63) - pb + gb;
    float* SC = (float*)(F.ws + WS_SC) + gh * 384;
    { const float glf = rdlane(gcf, 63), glb = rdlane(gcb, 0);
      SC[lane] = __expf(gcf); SC[64 + lane] = __expf(glf - gcf); if (lane == 0) SC[128] = __expf(glf);
      SC[192 + lane] = __expf(gcb); SC[256 + lane] = __expf(glb - gcb); if (lane == 0) SC[320] = __expf(glb); }
    LAS float* stw = (LAS float*)(F.lds + F.wave * 16384);
    LAS float* stash = stw + lane;
    {
        bf16x8 qf[2][8];
#pragma unroll
        for (int Ic = 0; Ic < 2; ++Ic) {
            load_norm_tile(raw, cw, sl, m0, p0, L, 32 * Ic, 128 * h, lane, 0.08838834764831845f, qf[Ic]);
            { char* qab = (char*)QA + (size_t)Ic * 8192; const unsigned lo16 = (unsigned)lane * 16u;
#pragma unroll
              for (int ks = 0; ks < 8; ++ks) *(bf16x8*)(qab + lo16 + ks * 1024) = qf[Ic][ks]; }
            __builtin_amdgcn_sched_barrier(0); }
#pragma unroll
        for (int Ic = 0; Ic < 2; ++Ic) {
#pragma unroll
            for (int Jr = 0; Jr < 2; ++Jr) { f32x16 a = {0};
#pragma unroll
                for (int ks = 0; ks < 8; ++ks) a = MFMA32(kf[Jr][ks], qf[Ic][ks], a);
#pragma unroll
                for (int r = 0; r < 16; ++r) stw[(32 * Jr + (r & 3) + 8 * (r >> 2) + 4 * hh) * 64 + 32 * Ic + r32] = a[r]; }
            __builtin_amdgcn_sched_barrier(0); }
        float M[64];
        if constexpr (DM & 1) { const int l1 = opaque(lane);
#pragma unroll
            for (int j = 0; j < 64; ++j) { const float dec = __expf(fminf(gcf - rdlane(gcf, j), 0.f)); const float kv = stash[j * 64] * dec; M[j] = l1 >= j ? kv : 0.f; __builtin_amdgcn_sched_barrier(0); }
            store_rows_as_afrags(M, (bf16*)(F.ws + WS_QKAF) + gh * 4096, lane); }
        if constexpr (DM & 2) { const int l2 = opaque(lane);
#pragma unroll
            for (int j = 0; j < 64; ++j) { const float dec = __expf(fminf(gcb - rdlane(gcb, j), 0.f)); const float kv = stash[j * 64] * dec; M[j] = l2 <= j ? kv : 0.f; __builtin_amdgcn_sched_barrier(0); }
            store_rows_as_afrags(M, (bf16*)(F.ws + WS_QKAB) + gh * 4096, lane); }
    }
    __builtin_amdgcn_sched_barrier(0);
    float Lf[64];
    {
#pragma unroll
        for (int Ic = 0; Ic < 2; ++Ic)
#pragma unroll
            for (int Jr = 0; Jr < 2; ++Jr) { f32x16 a = {0};
#pragma unroll
                for (int ks = 0; ks < 8; ++ks) a = MFMA32(kf[Jr][ks], kf[Ic][ks], a);
#pragma unroll
                for (int r = 0; r < 16; ++r) stw[(32 * Jr + (r & 3) + 8 * (r >> 2) + 4 * hh) * 64 + 32 * Ic + r32] = a[r]; }
        __builtin_amdgcn_sched_barrier(0);
        if constexpr (DM & 1) { const int l3 = opaque(lane); const float gcf3 = opaquef(gcf);
#pragma unroll
            for (int j = 0; j < 64; ++j) { const float df = __expf(fminf(gcf3 - rdlane(gcf3, j), 0.f));
                const float kv = bfw * stash[j * 64] * df; Lf[j] = l3 > j ? kv : 0.f; __builtin_amdgcn_sched_barrier(0); } }
    }
    if constexpr (DM & 1) {
        float M[64]; const int l4 = opaque(lane);
        M[63] = l4 == 63 ? 1.f : 0.f;
        subst_fwd<(DM & 16) != 0>(M, Lf, l4);
#pragma unroll
        for (int j = 0; j < 64; ++j) { M[j] *= rdlane(bfw, j); if ((j & 7) == 7) __builtin_amdgcn_sched_barrier(0); }
        store_rows_as_afrags(M, (bf16*)(F.ws + WS_TAF) + gh * 4096, lane);
    }
    __builtin_amdgcn_sched_barrier(0);
    if constexpr (DM & 2) {
        float M[64]; const int l5 = opaque(lane);
        M[0] = l5 == 0 ? 1.f : 0.f;
        subst_bwd<(DM & 16) != 0>(M, stash, bbw, opaquef(gcb), l5);
#pragma unroll
        for (int j = 0; j < 64; ++j) { M[j] *= rdlane(bbw, j); if ((j & 7) == 7) __builtin_amdgcn_sched_barrier(0); }
        store_rows_as_afrags(M, (bf16*)(F.ws + WS_TAB) + gh * 4096, lane);
    }
    if (!v_first) prep_v_images<DM>(F, raw, cw, m0, p0, L, h, gh, lane);
}

constexpr int SB_KA = 0, SB_QA = 16384, SB_KTA = 32768, SB_V = 49152, SB_TA = 65536, SB_QKA = 71680, SB_SC = 77824, SB_BYTES = 78592;
static_assert(2 * SB_BYTES <= LDSCTL_OFF, "scan buffers vs LDS control words");
__device__ __forceinline__ bf16x8 packB(const f32x16& x, int sh) {
    v4u p; p.x = pkc(x[8 * sh + 0], x[8 * sh + 1]); p.y = pkc(x[8 * sh + 2], x[8 * sh + 3]); p.z = pkc(x[8 * sh + 4], x[8 * sh + 5]); p.w = pkc(x[8 * sh + 6], x[8 * sh + 7]);
    return __builtin_bit_cast(bf16x8, p);
}
__device__ __forceinline__ void lds_rows16(const LAS float* base, int hh, float (&o)[16]) {
#pragma unroll
    for (int q = 0; q < 4; ++q) { const f32x4 v = *(const LAS f32x4*)(base + 8 * q + 4 * hh); o[4 * q] = v.x; o[4 * q + 1] = v.y; o[4 * q + 2] = v.z; o[4 * q + 3] = v.w; }
}
#define GLDS16(gsrc, ldst) __builtin_amdgcn_global_load_lds((const unsigned*)(gsrc), (LAS unsigned*)(ldst), 16, 0, 0)
#define GLDS4(gsrc, ldst) __builtin_amdgcn_global_load_lds((const unsigned*)(gsrc), (LAS unsigned*)(ldst), 4, 0, 0)
#ifndef SCAN_WARM
#define SCAN_WARM 0
#endif
constexpr int NLOAD = SCAN_WARM ? 3 : 4;
constexpr int SB_SINK = 2 * SB_BYTES;
static_assert(SB_SINK + 256 <= LDSCTL_OFF, "scan sink vs LDS control words");
template <int DIR, int P>
__device__ __forceinline__ void scan_piece(Frame& F, size_t gh, LAS unsigned char* B, unsigned lo16) {
    if constexpr (P < 16) GLDS16(F.ws + WS_KA + gh * 16384 + lo16 + P * 1024, B + SB_KA + P * 1024);
    else if constexpr (P < 32) GLDS16(F.ws + WS_QA + gh * 16384 + lo16 + (P - 16) * 1024, B + SB_QA + (P - 16) * 1024);
    else if constexpr (P < 48) GLDS16(F.ws + WS_KTA + gh * 16384 + lo16 + (P - 32) * 1024, B + SB_KTA + (P - 32) * 1024);
    else if constexpr (P < 64) GLDS16(F.ws + WS_VACC + gh * 16384 + lo16 + (P - 48) * 1024, B + SB_V + (P - 48) * 1024);
    else if constexpr (P < 70) { constexpr int slot = P - 64, fr = DIR ? (slot < 4 ? slot : slot + 2) : (slot < 2 ? slot : slot + 2); GLDS16(F.ws + (DIR ? WS_TAB : WS_TAF) + gh * 8192 + lo16 + fr * 1024, B + SB_TA + slot * 1024); }
    else if constexpr (P < 76) { constexpr int slot = P - 70, fr = DIR ? (slot < 4 ? slot : slot + 2) : (slot < 2 ? slot : slot + 2); GLDS16(F.ws + (DIR ? WS_QKAB : WS_QKAF) + gh * 8192 + lo16 + fr * 1024, B + SB_QKA + slot * 1024); }
    else { if (F.lane < 48) GLDS16(F.ws + WS_SC + (gh * 384 + DIR * 192) * 4 + lo16, B + SB_SC); }
}
template <int DIR, int LW, int P = LW>
__device__ __forceinline__ void scan_fill_lw(Frame& F, size_t gh, LAS unsigned char* B, unsigned lo16) {
    if constexpr (P < 77) { scan_piece<DIR, P>(F, gh, B, lo16); scan_fill_lw<DIR, LW, P + NLOAD>(F, gh, B, lo16); }
}
template <int DIR>
__device__ __forceinline__ void scan_fill(Frame& F, int lw, size_t gh, int buf) {
    const unsigned lo16 = (unsigned)F.lane * 16u;
    LAS unsigned char* B = F.lds + buf * SB_BYTES;
    if (lw == 0) scan_fill_lw<DIR, 0>(F, gh, B, lo16); else if (lw == 1) scan_fill_lw<DIR, 1>(F, gh, B, lo16); else if (lw == 2 || NLOAD == 3) scan_fill_lw<DIR, 2>(F, gh, B, lo16); else scan_fill_lw<DIR, 3>(F, gh, B, lo16);
}
template <int DIR>
__device__ __forceinline__ void scan_warm(Frame& F, size_t gh) {
    const unsigned l128 = (unsigned)F.lane * 128u; LAS unsigned char* sink = F.lds + SB_SINK;
#pragma unroll
    for (int i = 0; i < 2; ++i) { GLDS4(F.ws + WS_KA + gh * 16384 + i * 8192 + l128, sink); GLDS4(F.ws + WS_QA + gh * 16384 + i * 8192 + l128, sink);
        GLDS4(F.ws + WS_KTA + gh * 16384 + i * 8192 + l128, sink); GLDS4(F.ws + WS_VACC + gh * 16384 + i * 8192 + l128, sink); }
    GLDS4(F.ws + (DIR ? WS_TAB : WS_TAF) + gh * 8192 + l128, sink); GLDS4(F.ws + (DIR ? WS_QKAB : WS_QKAF) + gh * 8192 + l128, sink);
    if (F.lane < 6) GLDS4(F.ws + WS_SC + (gh * 384 + DIR * 192) * 4 + l128, sink);
}
#define SCAN_BAR() do { asm volatile("" ::: "memory"); __builtin_amdgcn_s_barrier(); asm volatile("" ::: "memory"); } while (0)
#define SCAN_LOADER_WAIT() asm volatile("s_waitcnt vmcnt(0)" ::: "memory")
template <int DIR>
__device__ __forceinline__ void dn_scan_block(Frame& F, int set, int b, int h) {
    const int N = set ? L_S / 64 : L_P / 64, g0 = set ? TP / 64 + b * (L_S / 64) : b * (L_P / 64);
    const int w = F.wave & 3;
    const bool loader = F.wave >= 4, warmer = SCAN_WARM && F.wave == 7;
    constexpr int AHEAD = 3;
#define GH_(st) ((size_t)(g0 + (DIR ? N - 1 - (st) : (st))) * NH + h)
#ifndef SCAN_REPS
#define SCAN_REPS 1
#endif
    f32x16 s[4];
#pragma unroll 1
    for (int rep__ = 0; rep__ < SCAN_REPS; ++rep__) {
#ifndef SCAN_PROBE
#define SCAN_PROBE 0
#endif
    const bool real__ = rep__ == SCAN_REPS - 1;
    const int lane = opaque(F.lane), r32 = lane & 31, hh = lane >> 5;
    if (warmer) { for (int st = 1; st < AHEAD && st < N; ++st) scan_warm<DIR>(F, GH_(st)); }
    else if (loader) { scan_fill<DIR>(F, w, GH_(0), 0); SCAN_LOADER_WAIT(); }
    else {
        if (set) { const float* s0 = (DIR ? F.in[I_SB] : F.in[I_SF]) + (size_t)(b * NH + h) * 128 * 128 + 32 * w + r32;
#pragma unroll
            for (int dt = 0; dt < 4; ++dt)
#pragma unroll
                for (int r = 0; r < 16; ++r) s[dt][r] = s0[(size_t)(32 * dt + crow(r, hh)) * 128];
        } else {
#pragma unroll
            for (int dt = 0; dt < 4; ++dt)
#pragma unroll
                for (int r = 0; r < 16; ++r) s[dt][r] = 0.f;
        }
    }
    SCAN_BAR();
#pragma unroll 1
    for (int step = 0; step < N; ++step) {
        const int n = DIR ? N - 1 - step : step;
        if (warmer) { if (step + AHEAD < N) scan_warm<DIR>(F, GH_(step + AHEAD)); }
        else if (loader) { if (step + 1 < N && (real__ || SCAN_PROBE != 1)) scan_fill<DIR>(F, w, GH_(step + 1), (step + 1) & 1); SCAN_LOADER_WAIT(); }
        else if (real__ || SCAN_PROBE != 2) {
            const LAS unsigned char* B = F.lds + (step & 1) * SB_BYTES;
            const unsigned lo16 = (unsigned)lane * 16u;
#define FR_(off, f) (*(const LAS bf16x8*)(B + (off) + lo16 + (f) * 1024))
            bf16x8 sB[4][2];
#pragma unroll
            for (int dt = 0; dt < 4; ++dt) { sB[dt][0] = packB(s[dt], 0); sB[dt][1] = packB(s[dt], 1); }
            f32x16 P[2], Oa[2];
            {
                constexpr int DEPTH = 4;
                bf16x8 win[DEPTH];
#define S1_OFF(i) ((((i) >> 4) ? SB_QA : SB_KA) + (((((i) >> 3) & 1) * 8 + ((i) & 7)) * 1024))
#pragma unroll
                for (int i = 0; i < DEPTH; ++i) win[i] = *(const LAS bf16x8*)(B + S1_OFF(i) + lo16);
                f32x16 acc4[2][2];
#pragma unroll
                for (int I = 0; I < 2; ++I) { acc4[I][0] = (f32x16){0}; acc4[I][1] = (f32x16){0}; }
#pragma unroll
                for (int i = 0; i < 32; ++i) { const int kq = i >> 4, I = (i >> 3) & 1, ks = i & 7;
                    acc4[I][kq] = MFMA32(win[i % DEPTH], sB[ks >> 1][ks & 1], acc4[I][kq]);
                    if (i + DEPTH < 32) win[i % DEPTH] = *(const LAS bf16x8*)(B + S1_OFF(i + DEPTH) + lo16); }
#undef S1_OFF
                P[0] = acc4[0][0]; Oa[0] = acc4[0][1]; P[1] = acc4[1][0]; Oa[1] = acc4[1][1];
                __builtin_amdgcn_sched_group_barrier(0x100, DEPTH, 0);
#pragma unroll
                for (int i = 0; i < 32 - DEPTH; ++i) { __builtin_amdgcn_sched_group_barrier(0x008, 1, 0); __builtin_amdgcn_sched_group_barrier(0x100, 1, 0); }
                __builtin_amdgcn_sched_group_barrier(0x008, DEPTH, 0);
            }
            const LAS float* SC = (const LAS float*)(B + SB_SC);
            bf16x8 inB[2][2];
#pragma unroll
            for (int I = 0; I < 2; ++I) { float eg[16]; lds_rows16(SC + 32 * I, hh, eg);
                const v4u v0 = *(const LAS v4u*)(B + SB_V + w * 4096 + I * 2048 + lane * 16), v1 = *(const LAS v4u*)(B + SB_V + w * 4096 + I * 2048 + 1024 + lane * 16);
                const unsigned vw[8] = {v0.x, v0.y, v0.z, v0.w, v1.x, v1.y, v1.z, v1.w};
#pragma unroll
                for (int r = 0; r < 16; ++r) { const float vv = (r & 1) ? bfhi(vw[r >> 1]) : bflo(vw[r >> 1]); P[I][r] = vv - eg[r] * P[I][r]; Oa[I][r] *= eg[r]; }
                inB[I][0] = packB(P[I], 0); inB[I][1] = packB(P[I], 1); }
            f32x16 V[2];
#pragma unroll
            for (int Ip = 0; Ip < 2; ++Ip) { f32x16 a = {0};
#pragma unroll
                for (int ks = 0; ks < 4; ++ks) if (DIR ? (Ip == 0 || ks >= 2) : (Ip == 1 || ks < 2)) a = MFMA32(FR_(SB_TA, Ip ? 2 + ks : ks), inB[ks >> 1][ks & 1], a);
                V[Ip] = a; }
            bf16x8 vB[2][2], vsB[2][2];
#pragma unroll
            for (int I = 0; I < 2; ++I) { float egl[16]; lds_rows16(SC + 64 + 32 * I, hh, egl);
                vB[I][0] = packB(V[I], 0); vB[I][1] = packB(V[I], 1);
#pragma unroll
                for (int r = 0; r < 16; ++r) V[I][r] *= egl[r];
                vsB[I][0] = packB(V[I], 0); vsB[I][1] = packB(V[I], 1); }
            unsigned char* Ob = F.ws + o_off(DIR, g0 + n) + (size_t)h * 16384 + w * 4096 + lane * 16;
#pragma unroll
            for (int Ip = 0; Ip < 2; ++Ip) {
#pragma unroll
                for (int ks = 0; ks < 4; ++ks) if (DIR ? (Ip == 0 || ks >= 2) : (Ip == 1 || ks < 2)) Oa[Ip] = MFMA32(FR_(SB_QKA, Ip ? 2 + ks : ks), vB[ks >> 1][ks & 1], Oa[Ip]);
                v4u o0, o1;
                o0.x = pkc(Oa[Ip][0], Oa[Ip][1]); o0.y = pkc(Oa[Ip][2], Oa[Ip][3]); o0.z = pkc(Oa[Ip][4], Oa[Ip][5]); o0.w = pkc(Oa[Ip][6], Oa[Ip][7]);
                o1.x = pkc(Oa[Ip][8], Oa[Ip][9]); o1.y = pkc(Oa[Ip][10], Oa[Ip][11]); o1.z = pkc(Oa[Ip][12], Oa[Ip][13]); o1.w = pkc(Oa[Ip][14], Oa[Ip][15]);
                *(v4u*)(Ob + Ip * 2048) = o0; *(v4u*)(Ob + Ip * 2048 + 1024) = o1; }
            const float gl = SC[128];
#pragma unroll
            for (int dt = 0; dt < 4; ++dt) { f32x16 a = s[dt] * gl;
                bf16x8 ft[4];
#pragma unroll
                for (int ks = 0; ks < 4; ++ks) ft[ks] = FR_(SB_KTA, dt * 4 + ks);
#pragma unroll
                for (int ks = 0; ks < 4; ++ks) a = MFMA32(ft[ks], vsB[ks >> 1][ks & 1], a);
                s[dt] = a; }
#undef FR_
        }
        SCAN_BAR();
    }
    }
    if (warmer) SCAN_LOADER_WAIT();
#undef GH_
    const int lane = F.lane, r32 = lane & 31, hh = lane >> 5;
    if (!loader && !set) { float* so = F.out + (size_t)T * D + (size_t)DIR * (NB_P * NH * 128 * 128) + (size_t)(b * NH + h) * 128 * 128 + 32 * w + r32;
#pragma unroll
        for (int dt = 0; dt < 4; ++dt)
#pragma unroll
            for (int r = 0; r < 16; ++r) so[(size_t)(32 * dt + crow(r, hh)) * 128] = s[dt][r]; }
}
__device__ __forceinline__ void dn_scan_phase(Frame& F) {
    const int bx = blockIdx.x;
    if (bx >= 192) return;
    int set, b, h, dir;
    if (bx < 64) { set = 1; b = bx >> 3; h = (bx >> 1) & 3; dir = bx & 1; } else { const int r = bx - 64; set = 0; b = r >> 3; h = (r >> 1) & 3; dir = r & 1;
        if (F.wave < 4) { const int item = ((b * (L_P / 64) + F.wave) * NH) + h; if (dir) dn_prep_item<2>(F, item); else dn_prep_item<1>(F, item); }
        asm volatile("s_waitcnt vmcnt(0)" ::: "memory"); __syncthreads(); }
    if (dir) dn_scan_block<1>(F, set, b, h); else dn_scan_block<0>(F, set, b, h);
}
__device__ __forceinline__ void conv_rows_queue(Frame& F) {
    const int lane = F.lane;
    const bf16* CB = (const bf16*)(F.ws + WS_CB); const bf16* UC = (const bf16*)(F.ws + WS_UC); bf16* YC = (bf16*)(F.ws + WS_YC);
    const float* cw = F.in[I_CONVW];
    float w0[8], w1[8], w2[8];
#pragma unroll
    for (int e = 0; e < 8; ++e) { w0[e] = cw[8 * lane + e]; w1[e] = cw[512 + 8 * lane + e]; w2[e] = cw[1024 + 8 * lane + e]; }
    for (;;) { const int mb = q_take(F.ctl + CW_Q_CONV, 16u, lane); if (mb >= T) break;
#pragma unroll 4
        for (int m = mb; m < mb + 16; ++m) {
            int p, dd, L;
            if (m < TP) { p = m & 255; dd = 1; L = 256; } else { p = (m - TP) & 4095; dd = 64; L = 4096; }
            const v4u z4 = {0u, 0u, 0u, 0u};
            const v4u c4 = *(const v4u*)(CB + (size_t)m * 512 + 8 * lane);
            const v4u u1 = *(const v4u*)(UC + (size_t)m * 512 + 8 * lane);
            const v4u u0 = p - dd >= 0 ? *(const v4u*)(UC + (size_t)(m - dd) * 512 + 8 * lane) : z4;
            const v4u u2 = p + dd < L ? *(const v4u*)(UC + (size_t)(m + dd) * 512 + 8 * lane) : z4;
            v4u y;
#pragma unroll
            for (int q = 0; q < 4; ++q) {
                const float lo = bflo(c4[q]) * (w0[2 * q] * bflo(u0[q]) + w1[2 * q] * bflo(u1[q]) + w2[2 * q] * bflo(u2[q]));
                const float hi = bfhi(c4[q]) * (w0[2 * q + 1] * bfhi(u0[q]) + w1[2 * q + 1] * bfhi(u1[q]) + w2[2 * q + 1] * bfhi(u2[q]));
                y[q] = pk2(lo, hi); }
            *(v4u*)(YC + (size_t)m * 512 + 8 * lane) = y;
        }
    }
}
__device__ __forceinline__ void post_phase(Frame& F) {
    const int gw = F.vcu * NWAVES + F.wave, NGW = F.G * NWAVES, lane = F.lane;
    const unsigned char* SZ = F.ws + WS_SZ; unsigned char* YD = F.ws + WS_YD;
    const float* dnn = F.in[I_DNNORM];
    const int r32 = lane & 31, hh = lane >> 5;
    LAS unsigned char* tile = F.lds + F.wave * 16384;
    float gn[4];
#pragma unroll
    for (int w = 0; w < 4; ++w) gn[w] = dnn[32 * w + r32];
    const int trow = lane >> 4, tcol = (lane & 15) * 16;
    constexpr int NIT = NCHUNK * NH * 2;
    const int nfull = NIT / NGW, rem = NIT - nfull * NGW;
#pragma unroll 1
    for (int k = 0; k <= nfull; ++k) {
        int it;
        if (k < nfull) it = gw + k * NGW; else { const int j = F.wave * F.G + F.vcu; if (j >= rem) break; it = nfull * NGW + j; }
        const int I = it & 1, h = (it >> 1) & 3, g = it >> 3;
        const size_t rowbase = ((size_t)g * 64 + 32 * I) * 1024 + 256 * h;
        v4u zz[8];
#pragma unroll
        for (int i = 0; i < 8; ++i) zz[i] = *(const v4u*)(SZ + rowbase + (size_t)(trow + 4 * i) * 1024 + tcol);
        const unsigned char* of = F.ws + o_off(0, g) + (size_t)h * 16384 + I * 2048 + lane * 16;
        const unsigned char* ob = F.ws + o_off(1, g) + (size_t)h * 16384 + I * 2048 + lane * 16;
        float o[4][16]; float ss[16];
#pragma unroll
        for (int r = 0; r < 16; ++r) ss[r] = 0.f;
#pragma unroll
        for (int w = 0; w < 4; ++w) { const v4u a0 = *(const v4u*)(of + w * 4096), a1 = *(const v4u*)(of + w * 4096 + 1024), b0 = *(const v4u*)(ob + w * 4096), b1 = *(const v4u*)(ob + w * 4096 + 1024);
            const unsigned aw[8] = {a0.x, a0.y, a0.z, a0.w, a1.x, a1.y, a1.z, a1.w}, bw[8] = {b0.x, b0.y, b0.z, b0.w, b1.x, b1.y, b1.z, b1.w};
#pragma unroll
            for (int r = 0; r < 16; ++r) { const float v = (r & 1) ? bfhi(aw[r >> 1]) + bfhi(bw[r >> 1]) : bflo(aw[r >> 1]) + bflo(bw[r >> 1]); o[w][r] = v; ss[r] += v * v; } }
#pragma unroll
        for (int i = 0; i < 8; ++i) *(LAS v4u*)(tile + (trow + 4 * i) * 264 + tcol) = zz[i];
#pragma unroll
        for (int r = 0; r < 16; ++r) { float t = ss[r]; t += __shfl_xor(t, 1); t += __shfl_xor(t, 2); t += __shfl_xor(t, 4); t += __shfl_xor(t, 8); t += __shfl_xor(t, 16); ss[r] = 1.0f / sqrtf(t * (1.f / 128.f) + EPS); }
#pragma unroll
        for (int r = 0; r < 16; ++r) { LAS unsigned short* rowp = (LAS unsigned short*)(tile + ((r & 3) + 8 * (r >> 2) + 4 * hh) * 264) + r32;
#pragma unroll
            for (int w = 0; w < 4; ++w) { const float z = bf2f(rowp[32 * w]); rowp[32 * w] = (unsigned short)f2bf(o[w][r] * ss[r] * gn[w] * z); } }
#pragma unroll
        for (int i = 0; i < 8; ++i) zz[i] = *(const LAS v4u*)(tile + (trow + 4 * i) * 264 + tcol);
#pragma unroll
        for (int i = 0; i < 8; ++i) *(v4u*)(YD + rowbase + (size_t)(trow + 4 * i) * 1024 + tcol) = zz[i];
    }
}

struct Args { const float* in[23]; float* out; unsigned char* ws; int ph_lo, ph_hi; };
__global__ void __launch_bounds__(NWAVES * 64, 2) mk_fwd(Args args) {
    extern __shared__ __attribute__((aligned(16))) unsigned char lds[];
    Frame F;
    F.lds = (LAS unsigned char*)lds;
    F.MISC = (volatile LAS unsigned*)(F.lds + MISC_OFF);
    F.tid = threadIdx.x; F.lane = F.tid & 63; F.wave = __builtin_amdgcn_readfirstlane(F.tid >> 6);
    F.G = gridDim.x; { const int bx = blockIdx.x; F.vcu = (F.G % 8 == 0) ? (bx % 8) * (F.G / 8) + bx / 8 : bx; }
    unsigned char* ws = args.ws; F.ws = ws; F.out = args.out;
    F.in = args.in;
    F.ctl = (gu32*)(ws + WS_CTL);
    for (int u = F.tid; u < (LDS_BYTES - LDSCTL_OFF) / 4; u += NWAVES * 64) ((LAS unsigned*)(F.lds + LDSCTL_OFF))[u] = 0u;
    __syncthreads();
    XcdBarrier bar; bar.bar = (unsigned*)(F.ctl + CW_BAR); bar.x = 0; bar.st = nullptr;
    const int lo = args.ph_lo, hi = args.ph_hi;
    if (hi - lo > 1) bar = xcd_barrier_post((unsigned*)(F.ctl + CW_BAR), F.MISC + 8);
    F.xcc = xb_xcc_id();
    if (F.tid == 0 && blockIdx.x < 192) __hip_atomic_fetch_add(F.ctl + CW_ECNT + 64 * F.xcc, 1u, RLX_AGENT);
#ifndef PH_MASK
#define PH_MASK 0xFFFF
#endif
#define IN(k) ((((PH_MASK) >> (k)) & 1) && lo <= (k) && (k) < hi)
#define SEAM(k) do { if (IN(k) && IN((k) + 1)) xcd_barrier(bar); } while (0)
#ifndef DUP_MASK
#define DUP_MASK 0
#endif
#define NREP(k) ((((DUP_MASK) >> (k)) & 1) ? 2 : 1)
#define REPB(k) _Pragma("unroll") for (int rep_ = 0; rep_ < NREP(k); ++rep_) { if (rep_) xcd_barrier(bar);
#define REPE }
    const float* mod = (const float*)(ws + WS_MOD);
    bf16* H = (bf16*)(ws + WS_H); bf16* ACT = (bf16*)(ws + WS_ACT);

    if (IN(0)) { REPB(0)  p0_prologue(F); REPE } SEAM(0);
#ifdef EXTRA_BARS
    for (int eb = 0; eb < EXTRA_BARS; ++eb) xcd_barrier(bar);
#endif
    if (IN(1)) { REPB(1)  norm_phase<0>(F, F.in[I_XP], F.in[I_XS], F.in[I_NF1], 0 * D, 1 * D, H); REPE } SEAM(1);
    if (IN(2)) { REPB(2)  pg8::Gemm g{H, (const bf16*)(ws + WS_WF1I), T, NFFI, D, D, H, 1 << 30}; pg8::StaticOrder S; S.init(T, NFFI, F.G, (int)blockIdx.x);
        pg8::EpiSwiglu E{ACT, FF}; pg8::gemm_phase<pg8::EpiSwiglu, pg8::StaticOrder, SWIGLU_ALIGN, GEMM_SP2>(F.lds + RING_OFF, g, S, E);
#if W2_IN_P0 == 2
        { constexpr int NLAST = (T / 256) * (NFFI / 256) - 12 * 256;
          if ((int)blockIdx.x >= NLAST && F.G == 256) ffn2_weights_static(F, (LAS float*)(F.lds + F.wave * 16384), ((int)blockIdx.x - NLAST) * NWAVES + F.wave, (256 - NLAST) * NWAVES); }
#endif
    REPE } SEAM(2);
    if (IN(3)) { pg8::Gemm g{ACT, (const bf16*)(ws + WS_WF1O), T, D, FF, FF, ACT, 1 << 30}; pg8::SplitOrder S; S.init(T, D, F.G, (int)blockIdx.x, 96 * 256, 192);
        pg8::EpiResid<false, true> E{F.in[I_XP], F.in[I_XS], TP, F.out, D, mod + 2 * D, NMOD, 0.5f}; pg8::gemm_phase<pg8::EpiResid<false, true>, pg8::SplitOrder, RESID_ALIGN, GEMM_SP2>(F.lds + RING_OFF, g, S, E);
        if (blockIdx.x < 192) { xcd_publish(F, F.ctl + CW_XPUB + 0 * 1024, __hip_atomic_load(F.ctl + CW_ECNT + 64 * F.xcc, RLX_AGENT), F.ctl + CW_EDONE + 64 * 0); panel_wait(F, F.ctl + CW_EDONE + 64 * 0, 192u); }
        if (blockIdx.x < 192) norm_rows<1, true>(F, F.out, (const bf16*)F.out + (size_t)TP * D, F.in[I_NMIX], 3 * D, 4 * D, H, 0, 96 * 256, (int)blockIdx.x * NWAVES + F.wave, 192 * NWAVES, 16, nullptr); } SEAM(3);
    if (IN(4)) { norm_rows<1, true>(F, F.out, (const bf16*)F.out + (size_t)TP * D, F.in[I_NMIX], 3 * D, 4 * D, H, NOSHADOW ? 0 : 96 * 256, T, F.vcu * NWAVES + F.wave, F.G * NWAVES, 1, nullptr, blockIdx.x >= 192 || !IN(3));        if (IN(5)) xcd_publish(F, F.ctl + CW_XPUB + 3 * 1024, F.MISC[8], F.ctl + CW_TAIL2); else {} }
    if (IN(5)) { REPB(5)  pg8::Gemm g{H, (const bf16*)(ws + WS_WMI), T, NMIX, D, D, H, 1 << 30}; pg8::TwoStageOrder S; S.init(T, NMIX, F.G, (int)blockIdx.x, 96 * 256, (const unsigned*)(F.ctl + CW_TAIL2), IN(4) ? (unsigned)F.G : 0u);
        pg8::EpiMixIn E{(bf16*)(ws + WS_CB), (bf16*)(ws + WS_UC), (bf16*)(ws + WS_QKV), (bf16*)(ws + WS_SZ)}; pg8::gemm_phase<pg8::EpiMixIn, pg8::TwoStageOrder, true, GEMM_SP2>(F.lds + RING_OFF, g, S, E); REPE } SEAM(5);
    if (IN(6)) { REPB(6)  for (int it = (TP / 64) * NH + F.wave * F.G + (int)blockIdx.x; it < NCHUNK * NH; it += NWAVES * F.G) { if (rep_ + 1 < NREP(6)) dn_prep_item<PREP_PROBE_DM>(F, it); else dn_prep_item<3>(F, it); }
#if W2_IN_P0 == 0
        ffn2_weights_queue(F, (LAS float*)(F.lds + F.wave * 16384));
#endif
    REPE } SEAM(6);
    if (IN(7)) { REPB(7)
        dn_scan_phase(F);
#if CONV_IN_SCAN
        if (blockIdx.x >= 64) conv_rows_queue(F);
#endif
    REPE } SEAM(7);
    if (IN(8)) { REPB(8)
#if !CONV_IN_SCAN
        conv_rows_queue(F);
#endif
        post_phase(F); REPE } SEAM(8);
    if (IN(9)) { pg8::Gemm g{(const bf16*)(ws + WS_YC), (const bf16*)(ws + WS_WMO), T, D, D, 512, (const bf16*)(ws + WS_YD) - 8 * 64, 8}; pg8::SplitOrder S; S.init(T, D, F.G, (int)blockIdx.x, 96 * 256, 192);
        pg8::EpiResid<true, true> E{F.out, (const bf16*)F.out + (size_t)TP * D, TP, ws + WS_X2B, D, mod + 5 * D, NMOD, 1.0f}; pg8::gemm_phase<pg8::EpiResid<true, true>, pg8::SplitOrder, RESID_ALIGN, GEMM_SP2, true>(F.lds + RING_OFF, g, S, E);
        if (blockIdx.x < 192) { xcd_publish(F, F.ctl + CW_XPUB + 1 * 1024, __hip_atomic_load(F.ctl + CW_ECNT + 64 * F.xcc, RLX_AGENT), F.ctl + CW_EDONE + 64 * 1); panel_wait(F, F.ctl + CW_EDONE + 64 * 1, 192u); }
        norm_rows<0, true>(F, ws + WS_X2B, (const bf16*)(ws + WS_X2B) + (size_t)TP * D, F.in[I_NF2], 6 * D, 7 * D, (bf16*)(ws + WS_H3), 0, 96 * 256, NOSHADOW ? -1 : (blockIdx.x < 192 ? (int)blockIdx.x * NWAVES + F.wave : -1), 192 * NWAVES, 16, nullptr); } SEAM(9);
    if (IN(10)) { norm_rows<0, true>(F, ws + WS_X2B, (const bf16*)(ws + WS_X2B) + (size_t)TP * D, F.in[I_NF2], 6 * D, 7 * D, (bf16*)(ws + WS_H3), NOSHADOW ? 0 : 96 * 256, T, F.vcu * NWAVES + F.wave, F.G * NWAVES, 1, nullptr); if (IN(11)) xcd_publish(F, F.ctl + CW_XPUB + 4 * 1024, F.MISC[8], F.ctl + CW_TAIL3); else {} }
    if (IN(11)) { REPB(11)  pg8::Gemm g{(const bf16*)(ws + WS_H3), (const bf16*)(ws + WS_WF2I), T, NFFI, D, D, (const bf16*)(ws + WS_H3), 1 << 30}; pg8::TwoStageOrder S; S.init(T, NFFI, F.G, (int)blockIdx.x, 96 * 256, (const unsigned*)(F.ctl + CW_TAIL3), IN(10) ? (unsigned)F.G : 0u);
        pg8::EpiSwiglu E{ACT, FF}; pg8::gemm_phase<pg8::EpiSwiglu, pg8::TwoStageOrder, SWIGLU_ALIGN, GEMM_SP2>(F.lds + RING_OFF, g, S, E); REPE } SEAM(11);
    if (IN(12)) { pg8::Gemm g{ACT, (const bf16*)(ws + WS_WF2O), T, D, FF, FF, ACT, 1 << 30}; pg8::SplitOrder S; S.init(T, D, F.G, (int)blockIdx.x, 96 * 256, 192);
        pg8::EpiResid<true, true> E{ws + WS_X2B, (const bf16*)(ws + WS_X2B) + (size_t)TP * D, TP, ws + WS_X2B, D, mod + 8 * D, NMOD, 0.5f}; pg8::gemm_phase<pg8::EpiResid<true, true>, pg8::SplitOrder,        RESID_ALIGN, GEMM_SP2>(F.lds + RING_OFF, g, S, E);
        if (blockIdx.x < 192) { xcd_publish(F, F.ctl + CW_XPUB + 2 * 1024, __hip_atomic_load(F.ctl + CW_ECNT + 64 * F.xcc, RLX_AGENT), F.ctl + CW_EDONE + 64 * 2); panel_wait(F, F.ctl + CW_EDONE + 64 * 2, 192u); }
        norm_rows<2, true>(F, ws + WS_X2B, (const bf16*)(ws + WS_X2B) + (size_t)TP * D, F.in[I_NFIN], 0, 0, nullptr, 0, 96 * 256, NOSHADOW ? -1 : (blockIdx.x < 192 ? (int)blockIdx.x * NWAVES + F.wave : -1), 192 * NWAVES, 16, nullptr); } SEAM(12);
    if (IN(13)) { norm_rows<2, true>(F, ws + WS_X2B, (const bf16*)(ws + WS_X2B) + (size_t)TP * D, F.in[I_NFIN], 0, 0, nullptr, NOSHADOW ? 0 : 96 * 256, T, F.vcu * NWAVES + F.wave, F.G * NWAVES, 1, nullptr); }
#undef IN
#undef SEAM
}

extern "C" void kernel_launch(void* const* d_in, const int* in_sizes, int n_in, void* d_out, int out_size, void* d_ws, size_t ws_size, hipStream_t stream) {
    static int grid = 0;
    if (grid == 0) {
        if (n_in != 23 || ws_size < WS_END) { fprintf(stderr, "kernel_launch: need 23 inputs and >= %zu bytes of workspace; got n_in %d, ws %zu\n", (size_t)WS_END, n_in, ws_size); grid = -1; return; }
        int dev = 0, cus = 0, per_cu = 0;
        if (hipGetDevice(&dev) != hipSuccess || hipDeviceGetAttribute(&cus, hipDeviceAttributeMultiprocessorCount, dev) != hipSuccess) { grid = -1; return; }
        if (hipFuncSetAttribute((const void*)mk_fwd, hipFuncAttributeMaxDynamicSharedMemorySize, LDS_BYTES) != hipSuccess) { fprintf(stderr, "kernel_launch: hipFuncSetAttribute failed\n"); grid = -1; return; }
        if (hipOccupancyMaxActiveBlocksPerMultiprocessor(&per_cu, (const void*)mk_fwd, NWAVES * 64, LDS_BYTES) != hipSuccess || per_cu < 1) { fprintf(stderr, "kernel_launch: occupancy query says %d blocks per CU\n", per_cu); grid = -1; (void)hipGetLastError(); return; }
        grid = cus;
    }
    if (grid < 0) return;
    (void)hipMemsetAsync((char*)d_ws + WS_CTL, 0, CTL_ZERO_BYTES, stream);
    Args a{};
    for (int i = 0; i < 23; ++i) a.in[i] = (const float*)d_in[i];
    a.out = (float*)d_out; a.ws = (unsigned char*)d_ws;
#if MK_N_LAUNCHES == 1
    a.ph_lo = 0; a.ph_hi = N_PHASES;
    hipLaunchKernelGGL(mk_fwd, dim3(grid), dim3(NWAVES * 64), LDS_BYTES, stream, a);
#else
    for (int p = 0; p < N_PHASES; ++p) { a.ph_lo = p; a.ph_hi = p + 1; hipLaunchKernelGGL(mk_fwd, dim3(grid), dim3(NWAVES * 64), LDS_BYTES, stream, a); }
#endif
}
```

```cpp
#include <hip/hip_runtime.h>
#include <cstdio>
#include <cstdint>
#include <cmath>
namespace pg8 {
#define PG8_LAS __attribute__((address_space(3)))
typedef unsigned short bf16_t;
typedef short bf16x8 __attribute__((ext_vector_type(8)));
typedef float f32x4 __attribute__((ext_vector_type(4)));
typedef unsigned u32x4 __attribute__((ext_vector_type(4)));
constexpr int BM = 256, BK = 64, HALF = 128, HTB = HALF * BK * 2  , STAGE_BYTES = 8 * HTB, NXCD = 8, WGM = 8;

__host__ __device__ __forceinline__ int lds_byte(int r, int c) { const int st = (r >> 4) * 2 + (c >> 5), rr = r & 15, cc = c & 31, ob = rr * 64 + cc * 2; return st * 1024 + (ob ^ (((ob >> 9) & 1) << 5)); }
__host__ __device__ __forceinline__ void stage_rc(int b, int& R, int& C) { const int st = b / 1024, sb = b % 1024, swz = sb ^ (((sb >> 9) & 1) << 5); R = (st >> 1) * 16 + swz / 64; C = (st & 1) * 32 + (swz % 64) / 2; }
__host__ __device__ __forceinline__ int perm32(int rho) { const int n = rho >> 4, i = rho & 15; return 8 * (i >> 2) + 4 * n + (i & 3); }

struct Unit { int pm, pn; };
struct Gemm { const bf16_t* A; const bf16_t* Bt; int M, N, K; int lda; const bf16_t* A2; int ksplit; };

struct StaticOrder {
    int nM, nN, nwg, G, c;
    __host__ __device__ void init(int M, int N, int G_, int c_) { nM = M / BM; nN = N / BM; nwg = nM * nN; G = G_; c = c_; }
    __host__ __device__ bool next(int i, Unit& u) const {
        const long L = (long)i * G + c; if (L >= nwg) return false;
        int wgid = (int)L; { const int q = nwg / NXCD, r = nwg % NXCD, xcd = wgid % NXCD, off = wgid / NXCD; wgid = (xcd < r ? xcd * (q + 1) : r * (q + 1) + (xcd - r) * q) + off; }
        const int nig = WGM * nN, gid = wgid / nig, fm = gid * WGM, gsz = (nM - fm) < WGM ? (nM - fm) : WGM;
        u.pm = fm + ((wgid % nig) % gsz); u.pn = (wgid % nig) / gsz; return true;
    }
    __device__ __forceinline__ void a_ready(const Unit&) const {}
    __device__ __forceinline__ void done(const Unit&) const {}
};
struct SplitOrder : StaticOrder {
    int pm_off, wgm;
    __host__ __device__ void init(int M, int N, int G_, int c_, int M0, int G0) { const bool lo = c_ < G0; StaticOrder::init(lo ? M0 : M - M0, N, lo ? G0 : G_ - G0, lo ? c_ : c_ - G0); pm_off = lo ? 0 : M0 / BM;
        wgm = (G / NXCD) / nN; if (wgm < 1) wgm = 1; }
    __host__ __device__ bool next(int i, Unit& u) const {
        const long L = (long)i * G + c; if (L >= nwg) return false;
        int wgid = (int)L; { const int q = nwg / NXCD, r = nwg % NXCD, xcd = wgid % NXCD, off = wgid / NXCD; wgid = (xcd < r ? xcd * (q + 1) : r * (q + 1) + (xcd - r) * q) + off; }
        const int nig = wgm * nN, gid = wgid / nig, fm = gid * wgm, gsz = (nM - fm) < wgm ? (nM - fm) : wgm;
        u.pm = pm_off + fm + ((wgid % nig) % gsz); u.pn = (wgid % nig) / gsz; return true;
    }
};
struct TwoStageOrder : StaticOrder {
    int nM0, n0; const unsigned* ctr; unsigned need; mutable int seen;
    __host__ __device__ void init(int M, int N, int G_, int c_, int M0, const unsigned* ctr_, unsigned need_) { StaticOrder::init(M, N, G_, c_); nM0 = M0 / BM; n0 = nM0 * nN; ctr = ctr_; need = need_; seen = 0; }
    __host__ __device__ bool next(int i, Unit& u) const {
        const long L = (long)i * G + c; if (L >= nwg) return false;
        const bool late = L >= n0; int wgid = late ? (int)L - n0 : (int)L; const int nw = late ? nwg - n0 : n0, nMs = late ? nM - nM0 : nM0;
        { const int q = nw / NXCD, r = nw % NXCD, xcd = wgid % NXCD, off = wgid / NXCD; wgid = (xcd < r ? xcd * (q + 1) : r * (q + 1) + (xcd - r) * q) + off; }
        const int nig = WGM * nN, gid = wgid / nig, fm = gid * WGM, gsz = (nMs - fm) < WGM ? (nMs - fm) : WGM;
        u.pm = (late ? nM0 : 0) + fm + ((wgid % nig) % gsz); u.pn = (wgid % nig) / gsz; return true;
    }
    __device__ __forceinline__ void a_ready(const Unit& u) const {
        if (u.pm >= nM0 && !seen) { seen = 1;
            if (threadIdx.x < 64) { unsigned spins = 0;
                while ((unsigned)__builtin_amdgcn_readfirstlane(__hip_atomic_load(ctr, __ATOMIC_RELAXED, __HIP_MEMORY_SCOPE_AGENT)) < need) { __builtin_amdgcn_s_sleep(8); if (++spins > (1u << 22)) break; }
                __builtin_amdgcn_fence(__ATOMIC_ACQUIRE, "agent");
                asm volatile("s_waitcnt vmcnt(0)" ::: "memory"); }
            __builtin_amdgcn_s_barrier(); }
    }
};

__device__ __forceinline__ unsigned cvt_pk_bf16(float lo, float hi) { unsigned r; asm volatile("v_cvt_pk_bf16_f32 %0, %1, %2" : "=v"(r) : "v"(lo), "v"(hi)); return r; }
__device__ __forceinline__ float silu_f(float a) { return a * __builtin_amdgcn_rcpf(1.0f + __expf(-a)); }

__device__ __forceinline__ float swiglu2(float a, float b) { return (a * b) * __builtin_amdgcn_rcpf(1.0f + __builtin_amdgcn_exp2f(-a)); }
#ifndef KLOOP_REPS
#define KLOOP_REPS_ 1
#else
#define KLOOP_REPS_ KLOOP_REPS
#endif
struct EpiSwiglu {
    static constexpr int KREP = KLOOP_REPS_;
    static constexpr bool PERM = true, AFTER_DRAIN = false;
    bf16_t* O; int ldc;
    __device__ __forceinline__ void operator()(const f32x4 (&acc)[2][2][4][2], const Unit& u, int wr, int wc, int fr, int fq) const {
        const int row0 = u.pm * BM + wr * 64 + fr, col0 = u.pn * HALF + wc * 32 + 8 * fq;
#pragma unroll
        for (int ai = 0; ai < 2; ++ai)
#pragma unroll
            for (int m = 0; m < 4; ++m) { bf16_t* rowp = O + (size_t)(row0 + ai * HALF + m * 16) * ldc + col0;
                const f32x4 a0 = acc[ai][0][m][0], a1 = acc[ai][0][m][1], b0 = acc[ai][1][m][0], b1 = acc[ai][1][m][1];
                u32x4 w;
                w.x = cvt_pk_bf16(swiglu2(a0[0], b0[0]), swiglu2(a0[1], b0[1])); w.y = cvt_pk_bf16(swiglu2(a0[2], b0[2]), swiglu2(a0[3], b0[3]));
                w.z = cvt_pk_bf16(swiglu2(a1[0], b1[0]), swiglu2(a1[1], b1[1])); w.w = cvt_pk_bf16(swiglu2(a1[2], b1[2]), swiglu2(a1[3], b1[3]));
                *(u32x4*)rowp = w; }
    }
};

template <bool BB, bool OB>
struct EpiResid {
    static constexpr int KREP = 1;
    static constexpr bool PERM = true, AFTER_DRAIN = false;
    const void* base0; const void* base1; int split_row; void* out; int ldc; const float* gate; int mod_ld; float coef;
    __device__ __forceinline__ void operator()(const f32x4 (&acc)[2][2][4][2], const Unit& u, int wr, int wc, int fr, int fq) const {
        const int row0 = u.pm * BM + wr * 64 + fr, col0 = u.pn * BM + wc * 32 + 8 * fq;
        const int midx = u.pm < 16 ? 0 : 1 + ((u.pm - 16) >> 4);
        const float* gp = gate + (size_t)midx * mod_ld + col0;
        f32x4 gv[2][2];
#pragma unroll
        for (int bj = 0; bj < 2; ++bj)
#pragma unroll
            for (int n = 0; n < 2; ++n) gv[bj][n] = *(const f32x4*)(gp + bj * HALF + n * 4) * coef;
#pragma unroll
        for (int ai = 0; ai < 2; ++ai)
#pragma unroll
            for (int m = 0; m < 4; ++m) { const int r = row0 + ai * HALF + m * 16;
                const size_t boff = (r < split_row ? (size_t)r : (size_t)(r - split_row)) * ldc + col0, ooff = (size_t)r * ldc + col0;
                const void* bsel = r < split_row ? base0 : base1;
#pragma unroll
                for (int bj = 0; bj < 2; ++bj) { f32x4 b0, b1;
                    if (BB) { const u32x4 w = *(const u32x4*)((const bf16_t*)bsel + boff + bj * HALF);
                        b0 = (f32x4){__builtin_bit_cast(float, w.x << 16), __builtin_bit_cast(float, w.x & 0xffff0000u), __builtin_bit_cast(float, w.y << 16), __builtin_bit_cast(float, w.y & 0xffff0000u)};
                        b1 = (f32x4){__builtin_bit_cast(float, w.z << 16), __builtin_bit_cast(float, w.z & 0xffff0000u), __builtin_bit_cast(float, w.w << 16), __builtin_bit_cast(float, w.w & 0xffff0000u)}; }
                    else { const float* bp = (const float*)bsel + boff + bj * HALF; b0 = *(const f32x4*)bp; b1 = *(const f32x4*)(bp + 4); }
                    const f32x4 o0 = b0 + gv[bj][0] * acc[ai][bj][m][0], o1 = b1 + gv[bj][1] * acc[ai][bj][m][1];
                    if (OB) { u32x4 w; w.x = cvt_pk_bf16(o0[0], o0[1]); w.y = cvt_pk_bf16(o0[2], o0[3]); w.z = cvt_pk_bf16(o1[0], o1[1]); w.w = cvt_pk_bf16(o1[2], o1[3]);
                        *(u32x4*)((bf16_t*)out + ooff + bj * HALF) = w; }
                    else { float* op = (float*)out + ooff + bj * HALF; *(f32x4*)op = o0; *(f32x4*)(op + 4) = o1; } }
            }
    }
};

struct EpiMixIn {
    static constexpr int KREP = 1;
    static constexpr bool PERM = true, AFTER_DRAIN = false;
    bf16_t* CB; bf16_t* UC; bf16_t* QKV; bf16_t* SZ;
    __device__ __forceinline__ void operator()(const f32x4 (&acc)[2][2][4][2], const Unit& u, int wr, int wc, int fr, int fq) const {
        const int row0 = u.pm * BM + wr * 64 + fr, lc = wc * 32 + 8 * fq;
        if (u.pn >= 2 && u.pn < 6) {
            const int col0 = (u.pn - 2) * HALF + lc;
#pragma unroll
            for (int ai = 0; ai < 2; ++ai)
#pragma unroll
                for (int m = 0; m < 4; ++m) { bf16_t* rowp = UC + (size_t)(row0 + ai * HALF + m * 16) * 512 + col0;
                    const f32x4 a0 = acc[ai][0][m][0], a1 = acc[ai][0][m][1], b0 = acc[ai][1][m][0], b1 = acc[ai][1][m][1];
                    u32x4 w; w.x = cvt_pk_bf16(a0[0] * b0[0], a0[1] * b0[1]); w.y = cvt_pk_bf16(a0[2] * b0[2], a0[3] * b0[3]);
                    w.z = cvt_pk_bf16(a1[0] * b1[0], a1[1] * b1[1]); w.w = cvt_pk_bf16(a1[2] * b1[2], a1[3] * b1[3]);
                    *(u32x4*)rowp = w; }
        } else {
            bf16_t* base; int ld, col0; bool act = false;
            if (u.pn < 2) { base = CB; ld = 512; col0 = u.pn * BM + lc; }
            else if (u.pn < 12) { base = QKV; ld = 1536; col0 = (u.pn - 6) * BM + lc; }
            else { base = SZ; ld = 512; col0 = (u.pn - 12) * BM + lc; act = true; }
#pragma unroll
            for (int ai = 0; ai < 2; ++ai)
#pragma unroll
                for (int m = 0; m < 4; ++m) { bf16_t* rowp = base + (size_t)(row0 + ai * HALF + m * 16) * ld + col0;
#pragma unroll
                    for (int bj = 0; bj < 2; ++bj) { f32x4 v0 = acc[ai][bj][m][0], v1 = acc[ai][bj][m][1];
                        if (act) { v0 = (f32x4){silu_f(v0[0]), silu_f(v0[1]), silu_f(v0[2]), silu_f(v0[3])}; v1 = (f32x4){silu_f(v1[0]), silu_f(v1[1]), silu_f(v1[2]), silu_f(v1[3])}; }
                        u32x4 w; w.x = cvt_pk_bf16(v0[0], v0[1]); w.y = cvt_pk_bf16(v0[2], v0[3]); w.z = cvt_pk_bf16(v1[0], v1[1]); w.w = cvt_pk_bf16(v1[2], v1[3]);
                        *(u32x4*)(rowp + bj * HALF) = w; } }
        }
    }
};

typedef float f32x2 __attribute__((ext_vector_type(2)));
template <class Epi, class Sched, bool ALIGN_EPI = false, bool SP2 = false, bool SPLITA = false>
__device__ __forceinline__ void gemm_phase(PG8_LAS unsigned char* lds, const Gemm g, const Sched& S, const Epi& E) {
    const int tid = threadIdx.x, wid = __builtin_amdgcn_readfirstlane(tid >> 6), lane = tid & 63, wr = wid >> 2, wc = wid & 3, fr = lane & 15, fq = lane >> 4;
    const int K = g.K, nt = K / BK;
    unsigned voffA[2], voffB[2];
#pragma unroll
    for (int i = 0; i < 2; ++i) { int R, C; stage_rc(tid * 16 + i * 8192, R, C); const int Rb = Epi::PERM ? ((R & ~31) + perm32(R & 31)) : R;
        voffA[i] = (unsigned)(R * g.lda + C) * 2u; voffB[i] = (unsigned)(Rb * K + C) * 2u; }
    const size_t kstep = (size_t)(BK * 2);
    const size_t hstep = (size_t)HALF * K * 2;
    const size_t tstep = 2 * hstep;
    const size_t hstepA = (size_t)HALF * g.lda * 2, tstepA = 2 * hstepA;
    const int ksplit = g.ksplit;
    const unsigned ldsw = (unsigned)wid * 1024u;
    const int aoff = lds_byte(wr * 64 + fr, fq * 8), boff = lds_byte(wc * 32 + fr, fq * 8);
#define PG8_SA(b, h) (((b) * 2 + (h)) * HTB)
#define PG8_SB(b, h) ((4 + (b) * 2 + (h)) * HTB)
#define PG8_STAGE(bufoff, gbase, voff) do { _Pragma("unroll") for (int _i = 0; _i < 2; ++_i) \
        __builtin_amdgcn_global_load_lds((const unsigned*)((const char*)(gbase) + (voff)[_i]), (PG8_LAS unsigned*)(lds + (bufoff) + ldsw + _i * 8192), 16, 0, 0); } while (0)
#define PG8_LDA(dst, b, h) do { _Pragma("unroll") for (int m = 0; m < 4; ++m) _Pragma("unroll") for (int k = 0; k < 2; ++k) dst[m][k] = *(const PG8_LAS bf16x8*)(lds + PG8_SA(b, h) + aoff + m * 2048 + k * 1024); } while (0)
#define PG8_LDB(dst, b, h) do { _Pragma("unroll") for (int n = 0; n < 2; ++n) _Pragma("unroll") for (int k = 0; k < 2; ++k) dst[n][k] = *(const PG8_LAS bf16x8*)(lds + PG8_SB(b, h) + boff + n * 2048 + k * 1024); } while (0)
#define PG8_MMA(ai, bj, At, Bt) do { __builtin_amdgcn_s_setprio(1); _Pragma("unroll") for (int m = 0; m < 4; ++m) _Pragma("unroll") for (int n = 0; n < 2; ++n) _Pragma("unroll") for (int k = 0; k < 2; ++k) \
        acc[ai][bj][m][n] = __builtin_amdgcn_mfma_f32_16x16x32_bf16(Bt[n][k], At[m][k], acc[ai][bj][m][n], 0, 0, 0); __builtin_amdgcn_s_setprio(0); } while (0)
#define PG8_WAIT_V(n) asm volatile("s_waitcnt vmcnt(" #n ")" ::: "memory")
#define PG8_WAIT_L(n) asm volatile("s_waitcnt lgkmcnt(" #n ")" ::: "memory")
#define PG8_BAR __builtin_amdgcn_s_barrier()
#define PG8_SCHED __builtin_amdgcn_sched_barrier(0)
    Unit cur, nxt; int ui = 0;
    if (!S.next(0, cur)) return;
    f32x4 acc[2][2][4][2];
#pragma unroll
    for (int a = 0; a < 2; ++a)
#pragma unroll
        for (int b = 0; b < 2; ++b)
#pragma unroll
            for (int m = 0; m < 4; ++m)
#pragma unroll
                for (int n = 0; n < 2; ++n) acc[a][b][m][n] = (f32x4){0.f, 0.f, 0.f, 0.f};
    bf16x8 At[4][2], B0[2][2], B1[2][2];
    const char* cA = (const char*)g.A + (size_t)cur.pm * tstepA; const char* cA2 = (const char*)g.A2 + (size_t)cur.pm * tstepA; const char* cB = (const char*)g.Bt + (size_t)cur.pn * tstep;
    S.a_ready(cur);
    if constexpr (SP2) {
        PG8_STAGE(PG8_SB(0, 0), cB, voffB); PG8_STAGE(PG8_SB(0, 1), cB + hstep, voffB); PG8_STAGE(PG8_SA(0, 0), cA, voffA); PG8_STAGE(PG8_SA(0, 1), cA + hstepA, voffA);
        if (wr == 1) PG8_BAR;
        PG8_WAIT_V(2); PG8_BAR;
        PG8_STAGE(PG8_SB(1, 0), cB + kstep, voffB); PG8_STAGE(PG8_SA(1, 0), cA + kstep, voffA); PG8_STAGE(PG8_SB(1, 1), cB + hstep + kstep, voffB);
        PG8_WAIT_V(6); PG8_BAR;
    } else {
        PG8_STAGE(PG8_SB(0, 0), cB, voffB); PG8_STAGE(PG8_SA(0, 0), cA, voffA); PG8_STAGE(PG8_SB(0, 1), cB + hstep, voffB); PG8_STAGE(PG8_SA(0, 1), cA + hstepA, voffA);
        if (wr == 1) PG8_BAR;
        PG8_WAIT_V(4); PG8_BAR;
        PG8_STAGE(PG8_SB(1, 0), cB + kstep, voffB); PG8_STAGE(PG8_SA(1, 0), cA + kstep, voffA); PG8_STAGE(PG8_SB(1, 1), cB + hstep + kstep, voffB);
        PG8_WAIT_V(6); PG8_BAR;
    }
    for (;;) {
        const bool has_next = S.next(ui + 1, nxt);
        const char* nA = has_next ? (const char*)g.A + (size_t)nxt.pm * tstepA : cA; const char* nB = has_next ? (const char*)g.Bt + (size_t)nxt.pn * tstep : cB;
#ifdef KLOOP_REPS
        constexpr int KR = Epi::KREP;
#else
        constexpr int KR = 1;
#endif
        for (int tt = 0; tt < nt * KR; tt += 2) {
            const int t = KR > 1 ? tt % nt : tt;
            const bool last = (tt == nt * KR - 2);
            const int t2 = (KR > 1 && t + 2 >= nt) ? 0 : t + 2;
            const char* a1 = (SPLITA && t + 1 >= ksplit ? cA2 : cA) + (size_t)(t + 1) * kstep;
            const char* a2 = last ? nA : (SPLITA && t2 >= ksplit ? cA2 : cA) + (size_t)t2 * kstep; const char* b2 = last ? nB : cB + (size_t)t2 * kstep;
            const char* a3 = a2 + kstep; const char* b3 = b2 + kstep;
            if (last && has_next) S.a_ready(nxt);
            if constexpr (SP2) {
            PG8_LDB(B0, 0, 0); PG8_LDB(B1, 0, 1); PG8_SCHED; PG8_LDA(At, 0, 0); PG8_STAGE(PG8_SA(1, 1), a1 + hstepA, voffA);
            PG8_WAIT_V(8); PG8_WAIT_L(0); PG8_BAR; PG8_MMA(0, 0, At, B0); PG8_MMA(0, 1, At, B1); PG8_BAR; PG8_SCHED;
            PG8_LDA(At, 0, 1); PG8_STAGE(PG8_SB(0, 0), b2, voffB); PG8_STAGE(PG8_SB(0, 1), b2 + hstep, voffB); PG8_STAGE(PG8_SA(0, 0), a2, voffA);
            PG8_WAIT_V(8); PG8_WAIT_L(0); PG8_BAR; PG8_MMA(1, 0, At, B0); PG8_MMA(1, 1, At, B1); PG8_BAR; PG8_SCHED;
            PG8_LDB(B0, 1, 0); PG8_LDB(B1, 1, 1); PG8_SCHED; PG8_LDA(At, 1, 0); PG8_STAGE(PG8_SA(0, 1), a2 + hstepA, voffA);
            PG8_WAIT_V(8); PG8_WAIT_L(0); PG8_BAR; PG8_MMA(0, 0, At, B0); PG8_MMA(0, 1, At, B1); PG8_BAR; PG8_SCHED;
            PG8_LDA(At, 1, 1); PG8_STAGE(PG8_SB(1, 0), b3, voffB); PG8_STAGE(PG8_SB(1, 1), b3 + hstep, voffB); PG8_STAGE(PG8_SA(1, 0), a3, voffA);
            PG8_WAIT_V(8); PG8_WAIT_L(0); PG8_BAR; PG8_MMA(1, 0, At, B0); PG8_MMA(1, 1, At, B1); PG8_BAR; PG8_SCHED;
            } else {
            PG8_LDB(B0, 0, 0); PG8_SCHED; PG8_LDA(At, 0, 0); PG8_STAGE(PG8_SA(1, 1), a1 + hstepA, voffA);
            PG8_WAIT_L(8); PG8_BAR; PG8_WAIT_L(0); PG8_MMA(0, 0, At, B0); PG8_BAR; PG8_SCHED;
            PG8_LDB(B1, 0, 1); PG8_STAGE(PG8_SB(0, 0), b2, voffB);
            PG8_BAR; PG8_WAIT_L(0); PG8_MMA(0, 1, At, B1); PG8_BAR;
            PG8_LDA(At, 0, 1); PG8_STAGE(PG8_SA(0, 0), a2, voffA);
            PG8_BAR; PG8_WAIT_L(0); PG8_MMA(1, 0, At, B0); PG8_BAR; PG8_SCHED;
            PG8_STAGE(PG8_SB(0, 1), b2 + hstep, voffB);
            PG8_WAIT_V(6); PG8_BAR; PG8_MMA(1, 1, At, B1); PG8_BAR;
            PG8_LDB(B0, 1, 0); PG8_SCHED; PG8_LDA(At, 1, 0); PG8_STAGE(PG8_SA(0, 1), a2 + hstepA, voffA);
            PG8_WAIT_L(8); PG8_BAR; PG8_WAIT_L(0); PG8_MMA(0, 0, At, B0); PG8_BAR; PG8_SCHED;
            PG8_LDB(B1, 1, 1); PG8_STAGE(PG8_SB(1, 0), b3, voffB);
            PG8_BAR; PG8_WAIT_L(0); PG8_MMA(0, 1, At, B1); PG8_BAR;
            PG8_LDA(At, 1, 1); PG8_STAGE(PG8_SA(1, 0), a3, voffA);
            PG8_BAR; PG8_WAIT_L(0); PG8_MMA(1, 0, At, B0); PG8_BAR; PG8_SCHED;
            PG8_STAGE(PG8_SB(1, 1), b3 + hstep, voffB);
            PG8_WAIT_V(6); PG8_BAR; PG8_MMA(1, 1, At, B1); PG8_BAR;
            }
        }
        if constexpr (ALIGN_EPI) { if (wr == 0) PG8_BAR; }
        if constexpr (KR > 1) {
#pragma unroll
            for (int a = 0; a < 2; ++a)
#pragma unroll
                for (int b = 0; b < 2; ++b)
#pragma unroll
                    for (int m = 0; m < 4; ++m)
#pragma unroll
                        for (int n = 0; n < 2; ++n) acc[a][b][m][n] *= (1.0f / KR); }
        if constexpr (!Epi::AFTER_DRAIN) { E(acc, cur, wr, wc, fr, fq); S.done(cur); }
        if (!has_next) break;
#pragma unroll
        for (int a = 0; a < 2; ++a)
#pragma unroll
            for (int b = 0; b < 2; ++b)
#pragma unroll
                for (int m = 0; m < 4; ++m)
#pragma unroll
                    for (int n = 0; n < 2; ++n) { f32x2 lo, hi; asm volatile("v_mov_b64 %0, 0" : "=v"(lo)); asm volatile("v_mov_b64 %0, 0" : "=v"(hi)); acc[a][b][m][n] = (f32x4){lo.x, lo.y, hi.x, hi.y}; }
        cur = nxt; cA = nA; cA2 = (const char*)g.A2 + (size_t)cur.pm * tstepA; cB = nB; ++ui;
        if constexpr (ALIGN_EPI) { if (wr == 1) PG8_BAR; }
    }
    PG8_WAIT_V(0);
    if constexpr (!ALIGN_EPI) { if (wr == 0) PG8_BAR; }
    PG8_BAR;
    if constexpr (Epi::AFTER_DRAIN) { E.fused(acc, cur, wr, wc, fr, fq, lds, wid, lane); S.done(cur); }
#undef PG8_SA
#undef PG8_SB
#undef PG8_STAGE
#undef PG8_LDA
#undef PG8_LDB
#undef PG8_MMA
#undef PG8_WAIT_V
#undef PG8_WAIT_L
#undef PG8_BAR
#undef PG8_SCHED
}
}

constexpr int NWAVES = 8;
constexpr int D = 1024, TP = 4096, TS = 32768, T = TP + TS, FF = 2816, NFFI = 2 * FF, NMIX = 3584, PROJ = 3600;
constexpr int NB_P = 16, L_P = 256, NB_S = 8, L_S = 4096, NH = 4, DKV = 128, NMOD = 9 * D;
constexpr float EPS = 1e-6f;
#ifndef MK_N_LAUNCHES
#define MK_N_LAUNCHES 1
#endif
constexpr int N_PHASES = 14;
#ifndef PREP_PROBE_DM
#define PREP_PROBE_DM 3
#endif
#ifndef GEMM_SP2
#define GEMM_SP2 true
#endif
#ifndef RESID_ALIGN
#define RESID_ALIGN true
#endif
#ifndef NOSHADOW
#define NOSHADOW 0
#endif
#ifndef SWIGLU_ALIGN
#define SWIGLU_ALIGN true
#endif
#ifndef W2_IN_P0
#define W2_IN_P0 2
#endif
#ifndef CONV_IN_SCAN
#define CONV_IN_SCAN 1
#endif

constexpr size_t MiB = 1u << 20;
constexpr size_t WS_CTL = 0, CTL_ZERO_BYTES = 256 * 1024;
constexpr size_t WS_MOD = 1 * MiB;
constexpr size_t WS_GSC = 2 * MiB, GSC_STRIDE = (size_t)T * 4 * 4;
constexpr size_t WS_WF1I = 6 * MiB, WS_WF1O = 17 * MiB, WS_WMI = 23 * MiB, WS_WMO = 30 * MiB, WS_WF2I = 32 * MiB, WS_WF2O = 43 * MiB;
constexpr size_t WS_H = 50 * MiB;
constexpr size_t WS_ACT = 122 * MiB;
constexpr size_t WS_CB = 122 * MiB, WS_UC = 158 * MiB, WS_SZ = 194 * MiB, WS_QKV = 230 * MiB;
constexpr size_t WS_END = 512 * MiB;
constexpr int CW_BAR = 4096;
constexpr int CW_ADA_DONE = 384;
constexpr int CW_Q_CONV = 64, CW_Q_WT = 128, CW_Q_N2 = 192, CW_Q_N3 = 256, CW_Q_NF = 320;
constexpr int CW_TAIL2 = 448, CW_TAIL3 = 512;
constexpr int CW_EDONE = 640;
constexpr int CW_XPUB = 8192, CW_ECNT = 14336;
constexpr int CW_RDY = 32768, RDY_BANK = 160 * 64;
constexpr size_t WS_YC = 306 * MiB;
constexpr size_t WS_YD = 50 * MiB;
constexpr size_t WS_X2B = 420 * MiB;
constexpr size_t WS_H3 = 342 * MiB;
static_assert((CW_RDY + 3 * RDY_BANK) * 4 <= (int)CTL_ZERO_BYTES && (CW_BAR + 3456) * 4 <= (int)CTL_ZERO_BYTES, "control words inside the per-call memset");

constexpr int RING_OFF = 0, RING_BYTES = 131072;
constexpr int LDS_BYTES = 163840;
constexpr int LDSCTL_OFF = LDS_BYTES - 512, MISC_OFF = LDSCTL_OFF + 320;

#define GAS __attribute__((address_space(1)))
#define LAS __attribute__((address_space(3)))
typedef unsigned short bf16;
typedef unsigned v4u __attribute__((ext_vector_type(4)));
typedef unsigned v2u __attribute__((ext_vector_type(2)));
typedef float f32x4 __attribute__((ext_vector_type(4)));
typedef short bf16x8 __attribute__((ext_vector_type(8)));
typedef GAS unsigned gu32;
#define RLX_AGENT __ATOMIC_RELAXED, __HIP_MEMORY_SCOPE_AGENT
#define LDS_WAIT() asm volatile("s_waitcnt lgkmcnt(0)" ::: "memory")
#define VM_WAIT() asm volatile("s_waitcnt vmcnt(0)" ::: "memory")
__device__ __forceinline__ unsigned f2bf(float f) { unsigned u = __builtin_bit_cast(unsigned, f); return (u + 0x7fffu + ((u >> 16) & 1u)) >> 16; }
__device__ __forceinline__ unsigned pk2(float lo, float hi) { return f2bf(lo) | (f2bf(hi) << 16); }
__device__ __forceinline__ float bf2f(unsigned short u) { return __builtin_bit_cast(float, (unsigned)u << 16); }
__device__ __forceinline__ float bflo(unsigned w) { return __builtin_bit_cast(float, w << 16); }
__device__ __forceinline__ float bfhi(unsigned w) { return __builtin_bit_cast(float, w & 0xffff0000u); }
__device__ __forceinline__ float siluf(float a) { return a / (1.0f + __expf(-a)); }
#define XB_TMO      128
#define XB_XCNT(j)  (256  + 64 * (j))
#define XB_XSUB(j)  (1280 + 64 * (j))
#define XB_XGEN(j)  (2304 + 64 * (j))
#define XB_TOP      3328
#define XB_TOPGEN   3392
#define XCD_BAR_WORDS 3456
#define XB_SPIN_CAP (1u << 18)

__device__ __forceinline__ unsigned xb_ld(unsigned* p)              { return __hip_atomic_load(p, __ATOMIC_RELAXED, __HIP_MEMORY_SCOPE_AGENT); }
__device__ __forceinline__ unsigned xb_add(unsigned* p, unsigned v) { return __hip_atomic_fetch_add(p, v, __ATOMIC_RELAXED, __HIP_MEMORY_SCOPE_AGENT); }
__device__ __forceinline__ unsigned xb_xcc_id() { return (unsigned)__builtin_amdgcn_s_getreg((3 << 11) | 20) & 0xFu; }
#define XB_SPIN(cond, bar) do { unsigned _sp = 0; while (cond) { if (_sp < 8u) __builtin_amdgcn_s_sleep(1); else __builtin_amdgcn_s_sleep(32); \
    if ((++_sp & 255u) == 0u) { if (xb_ld(&(bar)[XB_TMO])) break; if (_sp > XB_SPIN_CAP) { atomicAdd(&(bar)[XB_TMO], 1u); break; } } } } while (0)

struct XcdBarrier {
    unsigned* bar; unsigned x;
    volatile LAS unsigned* st;
};

__device__ __forceinline__ XcdBarrier xcd_barrier_post(unsigned* bar, volatile LAS unsigned* st) {
    XcdBarrier b; b.bar = bar; b.x = xb_xcc_id(); b.st = st;
    if (threadIdx.x == 0) (void)xb_add(&bar[XB_XCNT(b.x)], 1u);
    return b;
}
__device__ __forceinline__ void xcd_barrier_complete(unsigned* bar, unsigned x, unsigned& nloc, unsigned& nx) {
    const unsigned G = gridDim.x * gridDim.y * gridDim.z;
    unsigned sum, cnt, mine, sp = 0u;
    for (;;) {
        sum = 0u; cnt = 0u; mine = 0u;
#pragma unroll
        for (unsigned j = 0; j < 16; ++j) { const unsigned c = xb_ld(&bar[XB_XCNT(j)]); sum += c; cnt += (c > 0u) ? 1u : 0u; mine = (j == x) ? c : mine; }
        if (sum == G) break;
        __builtin_amdgcn_s_sleep(1);
        if ((++sp & 255u) == 0u) { if (xb_ld(&bar[XB_TMO])) break; if (sp > XB_SPIN_CAP) { atomicAdd(&bar[XB_TMO], 1u); break; } }
    }
    nloc = mine > 0u ? mine : 1u; nx = cnt > 0u ? cnt : 1u;
}

__device__ __forceinline__ void xcd_barrier(const XcdBarrier& b) {
    asm volatile("s_waitcnt vmcnt(0)" ::: "memory");
    __syncthreads();
    if (threadIdx.x == 0) {
        unsigned* bar = b.bar;
        __builtin_amdgcn_s_waitcnt(0);
        unsigned nloc = b.st[0], nx = b.st[1];
        if (nloc == 0u) { xcd_barrier_complete(bar, b.x, nloc, nx); b.st[0] = nloc; b.st[1] = nx; }
        const unsigned old = xb_add(&bar[XB_XSUB(b.x)], 1u);
        const unsigned gen = old / nloc;
        if (old + 1u == (gen + 1u) * nloc) {
            __builtin_amdgcn_fence(__ATOMIC_RELEASE, "agent");
            asm volatile("s_waitcnt vmcnt(0)" ::: "memory");
            const unsigned og = xb_add(&bar[XB_TOP], 1u);
            const unsigned tg = og / nx;
            if (og + 1u == (tg + 1u) * nx) xb_add(&bar[XB_TOPGEN], 1u);
            else XB_SPIN(xb_ld(&bar[XB_TOPGEN]) == tg, bar);
            __builtin_amdgcn_fence(__ATOMIC_ACQUIRE, "agent");
            xb_add(&bar[XB_XGEN(b.x)], 1u);
            asm volatile("s_waitcnt vmcnt(0)" ::: "memory");
        } else {
            XB_SPIN(xb_ld(&bar[XB_XGEN(b.x)]) == gen, bar);
            __builtin_amdgcn_fence(__ATOMIC_ACQUIRE, "agent");
            asm volatile("s_waitcnt vmcnt(0)" ::: "memory");
        }
    }
    __syncthreads();
}

struct Frame {
    LAS unsigned char* lds;
    volatile LAS unsigned* MISC;
    gu32* ctl;
    int tid, lane, wave;
    int vcu, G;
    unsigned xcc;
    const float* const* in; float* out; unsigned char* ws;
};
enum { I_XP = 0, I_XS, I_SF, I_SB, I_C, I_CCTX, I_WADA, I_BADA, I_NF1, I_WF1I, I_WF1O, I_NMIX, I_WMI, I_CONVW, I_DNCONVW, I_ALOG, I_DTB, I_DNNORM, I_WMO, I_NF2, I_WF2I, I_WF2O, I_NFIN };

__device__ __forceinline__ float wave_sum(float v) {
#pragma unroll
    for (int o = 1; o < 64; o <<= 1) v += __shfl_xor(v, o);
    return v;
}

__device__ __forceinline__ void p0_transpose_item(const float* W, int K, int ldw, bf16* WT, int kb, int n0, int drow, LAS float* scr, int lane, float scale = 1.0f) {
    const int k0 = 64 * kb;
    f32x4 tv[8];
#pragma unroll
    for (int i = 0; i < 8; ++i) { const int kk = 8 * i + (lane >> 3); tv[i] = *(const f32x4*)(W + (size_t)(k0 + kk) * ldw + n0 + 4 * (lane & 7)) * scale; }
#pragma unroll
    for (int i = 0; i < 8; ++i) { const int kk = 8 * i + (lane >> 3); LAS float* d = scr + kk * 33 + 4 * (lane & 7); d[0] = tv[i].x; d[1] = tv[i].y; d[2] = tv[i].z; d[3] = tv[i].w; }
    LDS_WAIT(); asm volatile("" ::: "memory");
    const int c = lane & 7;
#pragma unroll
    for (int j = 0; j < 4; ++j) { const int n = (lane >> 3) + 8 * j; const LAS float* s = scr + (8 * c) * 33 + n;
        v4u o; o.x = pk2(s[0 * 33], s[1 * 33]); o.y = pk2(s[2 * 33], s[3 * 33]); o.z = pk2(s[4 * 33], s[5 * 33]); o.w = pk2(s[6 * 33], s[7 * 33]);
        *(GAS v4u*)(WT + (size_t)(drow + n) * K + k0 + 8 * c) = o; }
    LDS_WAIT(); asm volatile("" ::: "memory");
}
__device__ __forceinline__ int ffi_drow(int n0) { return n0 < FF ? 256 * (n0 >> 7) + (n0 & 127) : 256 * ((n0 - FF) >> 7) + 128 + ((n0 - FF) & 127); }
__device__ __forceinline__ float ffi_scale(int n0) { return n0 < FF ? 1.44269504088896341f : 0.693147180559945309f; }
__device__ __forceinline__ int mi_drow(int n0) {
    if (n0 < 512 || n0 >= 1536) return n0;
    if (n0 < 1024) { const int j = n0 - 512; return 512 + 256 * (j >> 7) + (j & 127); }
    const int j = n0 - 1024; return 512 + 256 * (j >> 7) + 128 + (j & 127);
}

__device__ __forceinline__ void p0_prologue(Frame& F) {
    if ((int)blockIdx.x < NMOD / 64) {
        LAS float* sc = (LAS float*)(F.lds);
        LAS float* red = (LAS float*)(F.lds + 49152);
        { float cv[18];
#pragma unroll
          for (int i = 0; i < 18; ++i) { const int idx = F.tid + i * (NWAVES * 64), r = idx >> 10, k = idx & 1023; cv[i] = r == 0 ? F.in[I_CCTX][k] : F.in[I_C][(r - 1) * D + k]; }
#pragma unroll
          for (int i = 0; i < 18; ++i) { const int idx = F.tid + i * (NWAVES * 64), r = idx >> 10, k = idx & 1023; sc[k * 12 + r] = siluf(cv[i]); } }
        __syncthreads();
        const int n0 = blockIdx.x * 64; const float* W = F.in[I_WADA];
        const int c4 = F.lane & 15, rs = F.lane >> 4;
        f32x4 acc4[9];
#pragma unroll
        for (int r = 0; r < 9; ++r) acc4[r] = (f32x4){0.f, 0.f, 0.f, 0.f};
        const int kbeg = F.wave * 128;
#pragma unroll 1
        for (int kb = kbeg; kb < kbeg + 128; kb += 32) {
            f32x4 wv[8];
#pragma unroll
            for (int i = 0; i < 8; ++i) wv[i] = *(const f32x4*)(W + (size_t)(kb + 4 * i + rs) * NMOD + n0 + 4 * c4);
#pragma unroll
            for (int i = 0; i < 8; ++i) { const LAS float* s = sc + (kb + 4 * i + rs) * 12;
                const f32x4 s0 = *(const LAS f32x4*)s, s1 = *(const LAS f32x4*)(s + 4); const float s8 = s[8];
                acc4[0] += s0.x * wv[i]; acc4[1] += s0.y * wv[i]; acc4[2] += s0.z * wv[i]; acc4[3] += s0.w * wv[i];
                acc4[4] += s1.x * wv[i]; acc4[5] += s1.y * wv[i]; acc4[6] += s1.z * wv[i]; acc4[7] += s1.w * wv[i]; acc4[8] += s8 * wv[i]; } }
#pragma unroll
        for (int r = 0; r < 9; ++r) {
#pragma unroll
            for (int t = 0; t < 4; ++t) { float v = acc4[r][t]; v += __shfl_xor(v, 16); v += __shfl_xor(v, 32); acc4[r][t] = v; }
            if (rs == 0) *(LAS f32x4*)(red + (F.wave * 9 + r) * 64 + 4 * c4) = acc4[r]; }
        __syncthreads();
        for (int idx = F.tid; idx < 9 * 64; idx += NWAVES * 64) { const int r = idx >> 6, c = idx & 63; float s = F.in[I_BADA][n0 + c];
#pragma unroll
            for (int w = 0; w < 8; ++w) s += red[(w * 9 + r) * 64 + c];
            ((float*)(F.ws + WS_MOD))[r * NMOD + n0 + c] = s; }
        __syncthreads();
    }
    LAS float* scr = (LAS float*)(F.lds + RING_OFF + F.wave * 16384);
    const int gw = F.vcu * NWAVES + F.wave, NGW = F.G * NWAVES;
    constexpr int I_FI = (D / 64) * (NFFI / 32), I_FO = (FF / 64) * (D / 32), I_MI = (D / 64) * (NMIX / 32), I_MO = (D / 64) * (D / 32);
#if W2_IN_P0 == 1
    constexpr int NITEMS = 2 * I_FI + 2 * I_FO + I_MI + I_MO;
#else
    constexpr int NITEMS = I_FI + I_FO + I_MI + I_MO;
#endif
    constexpr int N_ADA_BLK = NMOD / 64, NW_A = N_ADA_BLK * NWAVES, NW_B = (256 - N_ADA_BLK) * NWAVES;
    constexpr int NITEMS_B = (int)((long)NITEMS * (NW_B * 28) / (NW_B * 28 + NW_A * 15));
    const bool ada_blk = (int)blockIdx.x < N_ADA_BLK && F.G == 256;
    const int it0 = F.G != 256 ? gw : (ada_blk ? NITEMS_B + (int)blockIdx.x * NWAVES + F.wave : ((int)blockIdx.x - N_ADA_BLK) * NWAVES + F.wave);
    const int it_end = F.G != 256 ? NITEMS : (ada_blk ? NITEMS : NITEMS_B), it_step = F.G != 256 ? NGW : (ada_blk ? NW_A : NW_B);
    for (int it = it0; it < it_end; it += it_step) {
        int r = it;
        if (r < I_FI) { const int nb = r % (NFFI / 32), kb = r / (NFFI / 32); p0_transpose_item(F.in[I_WF1I], D, NFFI, (bf16*)(F.ws + WS_WF1I), kb, 32 * nb, ffi_drow(32 * nb), scr, F.lane, ffi_scale(32 * nb)); continue; } r -= I_FI;
        if (r < I_FO) { const int nb = r % (D / 32), kb = r / (D / 32); p0_transpose_item(F.in[I_WF1O], FF, D, (bf16*)(F.ws + WS_WF1O), kb, 32 * nb, 32 * nb, scr, F.lane); continue; } r -= I_FO;
        if (r < I_MI) { const int nb = r % (NMIX / 32), kb = r / (NMIX / 32); p0_transpose_item(F.in[I_WMI], D, PROJ, (bf16*)(F.ws + WS_WMI), kb, 32 * nb, mi_drow(32 * nb), scr, F.lane); continue; } r -= I_MI;
        if (r < I_MO) { const int nb = r % (D / 32), kb = r / (D / 32); p0_transpose_item(F.in[I_WMO], D, D, (bf16*)(F.ws + WS_WMO), kb, 32 * nb, 32 * nb, scr, F.lane); continue; } r -= I_MO;
        if (r < I_FI) { const int nb = r % (NFFI / 32), kb = r / (NFFI / 32); p0_transpose_item(F.in[I_WF2I], D, NFFI, (bf16*)(F.ws + WS_WF2I), kb, 32 * nb, ffi_drow(32 * nb), scr, F.lane, ffi_scale(32 * nb)); continue; } r -= I_FI;
        { const int nb = r % (D / 32), kb = r / (D / 32); p0_transpose_item(F.in[I_WF2O], FF, D, (bf16*)(F.ws + WS_WF2O), kb, 32 * nb, 32 * nb, scr, F.lane); }
    }
}
__device__ __forceinline__ void wait_ada(Frame& F) {
    unsigned spins = 0;
    while ((unsigned)__builtin_amdgcn_readfirstlane(__hip_atomic_load(F.ctl + CW_ADA_DONE, RLX_AGENT)) < (unsigned)(NMOD / 64)) { __builtin_amdgcn_s_sleep(8); if (++spins > (1u << 22)) break; }
    __builtin_amdgcn_fence(__ATOMIC_ACQUIRE, "agent");
    asm volatile("s_waitcnt vmcnt(0)" ::: "memory");
}
__device__ __forceinline__ int q_take(gu32* head, unsigned n, int lane) {
    unsigned v = 0; if (lane == 0) v = __hip_atomic_fetch_add(head, n, RLX_AGENT);
    return (int)__builtin_amdgcn_readfirstlane(v);
}
__device__ __forceinline__ void ffn2_weights_queue(Frame& F, LAS float* scr) {
    constexpr int I_FI = (D / 64) * (NFFI / 32), I_FO = (FF / 64) * (D / 32);
    for (;;) { int r = q_take(F.ctl + CW_Q_WT, 1u, F.lane); if (r >= I_FI + I_FO) break;
        if (r < I_FI) { const int nb = r % (NFFI / 32), kb = r / (NFFI / 32); p0_transpose_item(F.in[I_WF2I], D, NFFI, (bf16*)(F.ws + WS_WF2I), kb, 32 * nb, ffi_drow(32 * nb), scr, F.lane, ffi_scale(32 * nb)); }
        else { r -= I_FI; const int nb = r % (D / 32), kb = r / (D / 32); p0_transpose_item(F.in[I_WF2O], FF, D, (bf16*)(F.ws + WS_WF2O), kb, 32 * nb, 32 * nb, scr, F.lane); } }
}

__device__ __forceinline__ void ffn2_weights_static(Frame& F, LAS float* scr, int wi, int nw) {
    constexpr int I_FI = (D / 64) * (NFFI / 32), I_FO = (FF / 64) * (D / 32);
    for (int r = wi; r < I_FI + I_FO; r += nw) {
        if (r < I_FI) { const int nb = r % (NFFI / 32), kb = r / (NFFI / 32); p0_transpose_item(F.in[I_WF2I], D, NFFI, (bf16*)(F.ws + WS_WF2I), kb, 32 * nb, ffi_drow(32 * nb), scr, F.lane, ffi_scale(32 * nb)); }
        else { const int q = r - I_FI; const int nb = q % (D / 32), kb = q / (D / 32); p0_transpose_item(F.in[I_WF2O], FF, D, (bf16*)(F.ws + WS_WF2O), kb, 32 * nb, 32 * nb, scr, F.lane); } }
}

#define NIDX(lane, j) (8 * (lane) + 512 * ((j) >> 1) + 4 * ((j) & 1))
template <bool SB> struct RowBuf;
template <> struct RowBuf<true> { v4u w[2]; };
template <> struct RowBuf<false> { f32x4 w[4]; };
template <bool SB>
__device__ __forceinline__ void norm_fetch(RowBuf<SB>& b, int m, const void* src0, const void* src1, int lane) {
    if constexpr (SB) { const bf16* xr = m < TP ? (const bf16*)src0 + (size_t)m * D : (const bf16*)src1 + (size_t)(m - TP) * D;
#pragma unroll
        for (int j = 0; j < 2; ++j) b.w[j] = *(const v4u*)(xr + 8 * lane + 512 * j); }
    else { const float* xr = m < TP ? (const float*)src0 + (size_t)m * D : (const float*)src1 + (size_t)(m - TP) * D;
#pragma unroll
        for (int j = 0; j < 4; ++j) b.w[j] = *(const f32x4*)(xr + NIDX(lane, j)); }
}
template <int MODE, bool SB>
__device__ __forceinline__ void norm_row(Frame& F, int m, const RowBuf<SB>& rb, const f32x4 (&gv)[4], const float* mod, int off_shift, int off_scale, bf16* H, LAS float* wab) {
        f32x4 v[4]; float s = 0.f;
        if constexpr (SB) {
#pragma unroll
            for (int j = 0; j < 2; ++j) { const v4u w = rb.w[j]; v[2 * j] = (f32x4){bflo(w.x), bfhi(w.x), bflo(w.y), bfhi(w.y)}; v[2 * j + 1] = (f32x4){bflo(w.z), bfhi(w.z), bflo(w.w), bfhi(w.w)}; } }
        else {
#pragma unroll
            for (int j = 0; j < 4; ++j) v[j] = rb.w[j]; }
#pragma unroll
        for (int j = 0; j < 4; ++j) { s += (v[j].x * v[j].x + v[j].y * v[j].y) + (v[j].z * v[j].z + v[j].w * v[j].w); }
        const float rstd = 1.0f / sqrtf(wave_sum(s) * (1.f / D) + EPS);
        if (MODE == 2) {
            float* o = F.out + (size_t)m * D;
#pragma unroll
            for (int j = 0; j < 4; ++j) *(f32x4*)(o + NIDX(F.lane, j)) = v[j] * rstd * gv[j];
        } else {
            const int midx = m < TP ? 0 : 1 + ((m - TP) >> 12);
            const float* mrow = mod + (size_t)midx * NMOD;
#pragma unroll
            for (int j = 0; j < 4; ++j) { const f32x4 sh = *(const f32x4*)(mrow + off_shift + NIDX(F.lane, j)), sc = *(const f32x4*)(mrow + off_scale + NIDX(F.lane, j));
                v[j] = v[j] * rstd * gv[j] * (sc + 1.0f) + sh; }
#pragma unroll
            for (int jp = 0; jp < 2; ++jp) { v4u w; w.x = pk2(v[2 * jp].x, v[2 * jp].y); w.y = pk2(v[2 * jp].z, v[2 * jp].w); w.z = pk2(v[2 * jp + 1].x, v[2 * jp + 1].y); w.w = pk2(v[2 * jp + 1].z, v[2 * jp + 1].w);
                *(v4u*)(H + (size_t)m * D + 8 * F.lane + 512 * jp) = w; }
            if (MODE == 1) {
                float acc[16];
#pragma unroll
                for (int o = 0; o < 16; ++o) acc[o] = 0.f;
                int fence = 0;
#pragma unroll
                for (int j = 0; j < 4; ++j) {
                    asm volatile("" : "+v"(fence), "+v"(acc[0]));
#pragma unroll
                    for (int o = 0; o < 16; ++o) { const f32x4 w = *(const LAS f32x4*)(wab + o * 1024 + 4 * F.lane + 256 * j + fence); acc[o] += (v[j].x * w.x + v[j].y * w.y) + (v[j].z * w.z + v[j].w * w.w); } }
                const bool b5 = F.lane & 32, b4 = F.lane & 16, b3 = F.lane & 8, b2 = F.lane & 4;
                float r8[8], r4[4], r2[2];
#pragma unroll
                for (int o = 0; o < 8; ++o) { const float mine = b5 ? acc[o + 8] : acc[o], oth = b5 ? acc[o] : acc[o + 8]; r8[o] = mine + __shfl_xor(oth, 32); }
#pragma unroll
                for (int o = 0; o < 4; ++o) { const float mine = b4 ? r8[o + 4] : r8[o], oth = b4 ? r8[o] : r8[o + 4]; r4[o] = mine + __shfl_xor(oth, 16); }
#pragma unroll
                for (int o = 0; o < 2; ++o) { const float mine = b3 ? r4[o + 2] : r4[o], oth = b3 ? r4[o] : r4[o + 2]; r2[o] = mine + __shfl_xor(oth, 8); }
                float r1 = (b2 ? r2[1] : r2[0]) + __shfl_xor(b2 ? r2[0] : r2[1], 4);
                r1 += __shfl_xor(r1, 2); r1 += __shfl_xor(r1, 1);
                float abq[4];
#pragma unroll
                for (int q = 0; q < 4; ++q) abq[q] = __shfl(r1, (F.lane & 12) | (q << 4));
                if ((F.lane & 0x33) == 0) { const int h = F.lane >> 2;
                    const float af = abq[0], bfv = abq[1], abk = abq[2], bb = abq[3];
                    const float* alog = F.in[I_ALOG]; const float* dtb = F.in[I_DTB];
                    const float xf = af + dtb[h], xb = abk + dtb[4 + h];
                    const float spf = xf > 20.f ? xf : log1pf(expf(xf)), spb = xb > 20.f ? xb : log1pf(expf(xb));
                    float* gsc = (float*)(F.ws + WS_GSC);
                    gsc[(size_t)m * 4 + h] = -expf(alog[h]) * spf;
                    gsc[(size_t)T * 4 + (size_t)m * 4 + h] = 1.0f / (1.0f + expf(-bfv));
                    gsc[(size_t)2 * T * 4 + (size_t)m * 4 + h] = -expf(alog[4 + h]) * spb;
                    gsc[(size_t)3 * T * 4 + (size_t)m * 4 + h] = 1.0f / (1.0f + expf(-bb));
                }
            }
        }
}
template <int MODE>
__device__ __forceinline__ void norm_setup(Frame& F, LAS float* wab) {
    if (MODE == 1) {
        const float* W = F.in[I_WMI];
        f32x4 t[8];
#pragma unroll
        for (int i = 0; i < 8; ++i) { const int idx4 = F.tid + i * (NWAVES * 64); t[i] = *(const f32x4*)(W + (size_t)(idx4 >> 2) * PROJ + NMIX + 4 * (idx4 & 3)); }
#pragma unroll
        for (int i = 0; i < 8; ++i) { const int idx4 = F.tid + i * (NWAVES * 64), k = idx4 >> 2, o = 4 * (idx4 & 3);
            const int pos = 4 * ((k & 511) >> 3) + 256 * (2 * (k >> 9) + ((k >> 2) & 1)) + (k & 3);
            wab[(o + 0) * 1024 + pos] = t[i].x; wab[(o + 1) * 1024 + pos] = t[i].y; wab[(o + 2) * 1024 + pos] = t[i].z; wab[(o + 3) * 1024 + pos] = t[i].w; }
        __syncthreads();
    }
}
template <int MODE>
__device__ __forceinline__ void norm_phase(Frame& F, const float* src0, const float* src1, const float* gnorm, int off_shift, int off_scale, bf16* H) {
    const int gw = F.vcu * NWAVES + F.wave, NGW = F.G * NWAVES;
    LAS float* wab = (LAS float*)F.lds;
    norm_setup<MODE>(F, wab);
    const float* mod = (const float*)(F.ws + WS_MOD);
    f32x4 gv[4];
#pragma unroll
    for (int j = 0; j < 4; ++j) gv[j] = *(const f32x4*)(gnorm + NIDX(F.lane, j));
    RowBuf<false> cur, nxt;
    if (gw < T) norm_fetch<false>(cur, gw, src0, src1, F.lane);
#pragma unroll 1
    for (int m = gw; m < T; m += NGW) { const bool more = m + NGW < T; if (more) norm_fetch<false>(nxt, m + NGW, src0, src1, F.lane);
        norm_row<MODE, false>(F, m, cur, gv, mod, off_shift, off_scale, H, wab); if (more) cur = nxt; }
}
template <class Order>
__device__ __forceinline__ void publish_units(Frame& F, const Order& S, gu32* ready) {
    if (F.tid == 0) {
        __builtin_amdgcn_fence(__ATOMIC_RELEASE, "agent");
        asm volatile("s_waitcnt vmcnt(0)" ::: "memory");
        pg8::Unit u; for (int i = 0; S.next(i, u); ++i) __hip_atomic_fetch_add(ready + 64 * u.pm, 1u, RLX_AGENT);
    }
}
template <int MODE, bool SB>
__device__ __forceinline__ void norm_rows(Frame& F, const void* src0, const void* src1, const float* gnorm, int off_shift, int off_scale, bf16* H, int m0, int m1, int wi, int nw, int rows_per_wave, gu32* ready, bool setup = true) {
    LAS float* wab = (LAS float*)F.lds;
    if (setup) norm_setup<MODE>(F, wab);
    if (wi < 0) return;
    const float* mod = (const float*)(F.ws + WS_MOD);
    f32x4 gv[4];
#pragma unroll
    for (int j = 0; j < 4; ++j) gv[j] = *(const f32x4*)(gnorm + NIDX(F.lane, j));
    (void)ready;
    const int step = nw * rows_per_wave;
    int mb = m0 + wi * rows_per_wave, m = mb;
    RowBuf<SB> cur, nxt;
    if (m < m1) norm_fetch<SB>(cur, m, src0, src1, F.lane);
#pragma unroll 1
    while (m < m1) {
        int m2 = m + 1, mb2 = mb; if (m2 >= mb + rows_per_wave || m2 >= m1) { mb2 = mb + step; m2 = mb2; }
        const bool more = m2 < m1; if (more) norm_fetch<SB>(nxt, m2, src0, src1, F.lane);
        norm_row<MODE, SB>(F, m, cur, gv, mod, off_shift, off_scale, H, wab);
        if (more) cur = nxt;
        m = m2; mb = mb2;
    }
}
__device__ __forceinline__ void tail_publish(Frame& F, gu32* ctr) {
    asm volatile("s_waitcnt vmcnt(0)" ::: "memory");
    __syncthreads();
    if (F.tid == 0) { __builtin_amdgcn_fence(__ATOMIC_RELEASE, "agent"); asm volatile("s_waitcnt vmcnt(0)" ::: "memory"); __hip_atomic_fetch_add(ctr, 1u, RLX_AGENT); }
}
__device__ __forceinline__ void panel_wait(Frame& F, gu32* rp, unsigned need) {
    if (F.wave == 0) { unsigned spins = 0;
        while ((unsigned)__builtin_amdgcn_readfirstlane(__hip_atomic_load(rp, RLX_AGENT)) < need) { __builtin_amdgcn_s_sleep(8); if (++spins > (1u << 22)) break; }
        __builtin_amdgcn_fence(__ATOMIC_ACQUIRE, "agent");
        asm volatile("s_waitcnt vmcnt(0)" ::: "memory"); }
    __syncthreads();
}
__device__ __forceinline__ void xcd_publish(Frame& F, gu32* xsub, unsigned expected_local, gu32* gctr) {
    asm volatile("s_waitcnt vmcnt(0)" ::: "memory");
    __syncthreads();
    if (F.tid == 0) {
        const unsigned old = __hip_atomic_fetch_add(xsub + 64 * F.xcc, 1u, RLX_AGENT);
        if (old + 1u == expected_local) { __builtin_amdgcn_fence(__ATOMIC_RELEASE, "agent"); asm volatile("s_waitcnt vmcnt(0)" ::: "memory"); __hip_atomic_fetch_add(gctr, expected_local, RLX_AGENT); }
    }
}

typedef float f32x16 __attribute__((ext_vector_type(16)));
typedef __bf16 bf16x2_t __attribute__((ext_vector_type(2)));
typedef float f32x2_t __attribute__((ext_vector_type(2)));
#define MFMA32(a, b, c) __builtin_amdgcn_mfma_f32_32x32x16_bf16((a), (b), (c), 0, 0, 0)
__device__ __forceinline__ unsigned pkc(float lo, float hi) { f32x2_t v = {lo, hi}; bf16x2_t b = __builtin_convertvector(v, bf16x2_t); return __builtin_bit_cast(unsigned, b); }
__device__ __forceinline__ float rdlane(float v, int l) { return __builtin_bit_cast(float, __builtin_amdgcn_readlane(__builtin_bit_cast(int, v), l)); }
__device__ __forceinline__ float silu_fast(float a) { return a * __builtin_amdgcn_rcpf(1.0f + __expf(-a)); }
__device__ __forceinline__ int opaque(int x) { asm volatile("" : "+v"(x)); return x; }
__device__ __forceinline__ float opaquef(float x) { asm volatile("" : "+v"(x)); return x; }
__device__ __forceinline__ int crow(int r, int hh) { return (r & 3) + 8 * (r >> 2) + 4 * hh; }

constexpr int NCHUNK = T / 64;
constexpr size_t WS_QA = 342 * MiB, WS_KA = 378 * MiB, WS_KTA = 414 * MiB, WS_VACC = 450 * MiB;
constexpr size_t WS_TAF = 486 * MiB, WS_SC = 504 * MiB;
constexpr size_t WS_TAB = 50 * MiB, WS_QKAF = 68 * MiB, WS_QKAB = 86 * MiB;
__device__ __forceinline__ size_t o_off(int dir, int g) { return (g < TP / 64 ? (104 + 4 * (size_t)dir) * MiB : (238 + 32 * (size_t)dir) * MiB) + (size_t)g * 65536; }
static_assert(WS_SC + (size_t)NCHUNK * NH * 384 * 4 <= WS_END, "DN scalars vs workspace end");

__device__ __forceinline__ void store_rows_as_afrags(const float (&M)[64], bf16* dst, int lane) {
#pragma unroll
    for (int ks = 0; ks < 4; ++ks) {
        unsigned pa[4], pb[4];
        pa[0] = pkc(M[16 * ks + 0], M[16 * ks + 1]); pa[1] = pkc(M[16 * ks + 2], M[16 * ks + 3]); pa[2] = pkc(M[16 * ks + 8], M[16 * ks + 9]); pa[3] = pkc(M[16 * ks + 10], M[16 * ks + 11]);
        pb[0] = pkc(M[16 * ks + 4], M[16 * ks + 5]); pb[1] = pkc(M[16 * ks + 6], M[16 * ks + 7]); pb[2] = pkc(M[16 * ks + 12], M[16 * ks + 13]); pb[3] = pkc(M[16 * ks + 14], M[16 * ks + 15]);
#pragma unroll
        for (int q = 0; q < 4; ++q) { const auto r = __builtin_amdgcn_permlane32_swap(pa[q], pb[q], false, false); pa[q] = r[0]; pb[q] = r[1]; }
        v4u fa = {pa[0], pa[1], pa[2], pa[3]}, fb = {pb[0], pb[1], pb[2], pb[3]};
        *(v4u*)((char*)dst + (unsigned)lane * 16u + ks * 1024) = fa;
        *(v4u*)((char*)dst + 4096 + (unsigned)lane * 16u + ks * 1024) = fb;
        __builtin_amdgcn_sched_barrier(0);
    }
}

__device__ __forceinline__ void conv4(const v2u x0, const v2u x1, const v2u x2, const f32x4 w0, const f32x4 w1, const f32x4 w2, float (&o)[4]) {
    o[0] = silu_fast(w0.x * bflo(x0.x) + w1.x * bflo(x1.x) + w2.x * bflo(x2.x));
    o[1] = silu_fast(w0.y * bfhi(x0.x) + w1.y * bfhi(x1.x) + w2.y * bfhi(x2.x));
    o[2] = silu_fast(w0.z * bflo(x0.y) + w1.z * bflo(x1.y) + w2.z * bflo(x2.y));
    o[3] = silu_fast(w0.w * bfhi(x0.y) + w1.w * bfhi(x1.y) + w2.w * bfhi(x2.y));
}
__device__ __forceinline__ void stage_raw_tile(const bf16* raw, const float* cw, LAS unsigned char* sl, int m0, int p0, int L, int tok0, int colbase, int lane) {
        v4u st[9];
#pragma unroll
        for (int i = 0; i < 9; ++i) { const int pidx = lane + 64 * i, row = pidx >> 4, c16 = pidx & 15, t = tok0 - 1 + row;
            const bool ok = pidx < 544 && p0 + t >= 0 && p0 + t < L;
            st[i] = ok ? *(const v4u*)((const char*)raw + ((size_t)(m0 + t) * 1536 + colbase) * 2 + c16 * 16) : (v4u){0u, 0u, 0u, 0u}; }
        f32x4 wt[2];
#pragma unroll
        for (int i = 0; i < 2; ++i) { const int idx4 = lane + 64 * i; wt[i] = idx4 < 96 ? *(const f32x4*)(cw + (idx4 >> 5) * 1536 + colbase + 4 * (idx4 & 31)) : (f32x4){0.f, 0.f, 0.f, 0.f}; }
#pragma unroll
        for (int i = 0; i < 9; ++i) { const int pidx = lane + 64 * i, row = pidx >> 4, c16 = pidx & 15;
            if (pidx < 544) { LAS v2u* d = (LAS v2u*)(sl + row * 264 + c16 * 16); d[0] = (v2u){st[i].x, st[i].y}; d[1] = (v2u){st[i].z, st[i].w}; } }
#pragma unroll
        for (int i = 0; i < 2; ++i) { const int idx4 = lane + 64 * i; if (idx4 < 96) ((LAS f32x4*)(sl + 8976))[idx4] = wt[i]; }
    }
__device__ __forceinline__ void load_norm_tile(const bf16* raw, const float* cw, LAS unsigned char* sl, int m0, int p0, int L, int tok0, int colbase, int lane, float scale, bf16x8 (&frag)[8]) {
    const int r32 = lane & 31, hh = lane >> 5;
    stage_raw_tile(raw, cw, sl, m0, p0, L, tok0, colbase, lane);
    float f[8][8]; float ss = 0.f;
    const LAS unsigned char* rp = sl + r32 * 264 + 8 * hh;
    const LAS float* wp = (const LAS float*)(sl + 8976) + 4 * hh;
    int fence = 0;
#pragma unroll
    for (int ks = 0; ks < 8; ++ks) {
        asm volatile("" : "+v"(fence), "+v"(ss));
#pragma unroll
        for (int pc = 0; pc < 2; ++pc) { const int cb = 32 * ks + 16 * pc;
            const v2u x0 = *(const LAS v2u*)(rp + cb + fence), x1 = *(const LAS v2u*)(rp + 264 + cb + fence), x2 = *(const LAS v2u*)(rp + 528 + cb + fence);
            const f32x4 w0 = *(const LAS f32x4*)(wp + cb / 2), w1 = *(const LAS f32x4*)(wp + 128 + cb / 2), w2 = *(const LAS f32x4*)(wp + 256 + cb / 2);
            float o[4]; conv4(x0, x1, x2, w0, w1, w2, o);
#pragma unroll
            for (int e = 0; e < 4; ++e) { f[ks][4 * pc + e] = o[e]; ss += o[e] * o[e]; } }
    }
    ss += __shfl_xor(ss, 32);
    const float rn = scale * __builtin_amdgcn_rsqf(ss + EPS);
#pragma unroll
    for (int ks = 0; ks < 8; ++ks) { v4u p; p.x = pkc(f[ks][0] * rn, f[ks][1] * rn); p.y = pkc(f[ks][2] * rn, f[ks][3] * rn); p.z = pkc(f[ks][4] * rn, f[ks][5] * rn); p.w = pkc(f[ks][6] * rn, f[ks][7] * rn);
        frag[ks] = __builtin_bit_cast(bf16x8, p); }
}

template <int J, int C0, bool FAKE>
__device__ __forceinline__ void subst_chunk(float (&M)[64], float negl, int lo, int hi) {
    float t[8];
#pragma unroll
    for (int e = 0; e < 8; ++e) if (C0 + e >= lo && C0 + e <= hi) t[e] = FAKE ? M[C0 + e] * 0.5f : rdlane(M[C0 + e], J);
    __builtin_amdgcn_sched_barrier(0);
#pragma unroll
    for (int e = 0; e < 8; ++e) if (C0 + e >= lo && C0 + e <= hi) M[C0 + e] = fmaf(negl, t[e], M[C0 + e]);
    __builtin_amdgcn_sched_barrier(0);
}
template <int J, int LO, int HI, bool FAKE, int C0 = 0>
__device__ __forceinline__ void subst_row(float (&M)[64], float negl) {
    if constexpr (C0 < 64) { if constexpr (C0 + 7 >= LO && C0 <= HI) subst_chunk<J, C0, FAKE>(M, negl, LO, HI); subst_row<J, LO, HI, FAKE, C0 + 8>(M, negl); }
}
template <bool FAKE, int J = 0>
__device__ __forceinline__ void subst_fwd(float (&M)[64], const float (&L)[64], int lane) {
    if constexpr (J < 63) { M[J] = lane == J ? 1.f : 0.f; subst_row<J, 0, J, FAKE>(M, -L[J]); subst_fwd<FAKE, J + 1>(M, L, lane); }
}
template <bool FAKE, int J = 63>
__device__ __forceinline__ void subst_bwd(float (&M)[64], const LAS float* stash, float bbw, float gcb, int lane) {
    if constexpr (J > 0) { const float lbv = bbw * stash[J * 64] * __expf(fminf(gcb - rdlane(gcb, J), 0.f)); const float lb = lane < J ? lbv : 0.f; M[J] = lane == J ? 1.f : 0.f;
        subst_row<J, J, 63, FAKE>(M, -lb); subst_bwd<FAKE, J - 1>(M, stash, bbw, gcb, lane); }
}

template <int DM>
__device__ __forceinline__ void prep_v_images(Frame& F, const bf16* raw, const float* cw, int m0, int p0, int L, int h, size_t gh, int lane) {
    if constexpr (!(DM & 4)) {
        bf16* VA = (bf16*)(F.ws + WS_VACC) + gh * 8192;
        LAS unsigned char* sl = F.lds + F.wave * 16384;
#pragma unroll 1
        for (int I = 0; I < 2; ++I) {
            stage_raw_tile(raw, cw, sl, m0, p0, L, 32 * I, 1024 + 128 * h, lane);
            asm volatile("s_waitcnt lgkmcnt(0)" ::: "memory");
#pragma unroll 1
            for (int pass = 0; pass < 2; ++pass) { const int d = 64 * pass + lane;
                const LAS float* wp = (const LAS float*)(sl + 8976) + d;
                const float w0 = wp[0], w1 = wp[128], w2 = wp[256];
                const LAS unsigned short* cp = (const LAS unsigned short*)sl + d;
                float xm = bf2f(cp[0]), xc = bf2f(cp[132]);
                float vv[32];
#pragma unroll
                for (int t = 0; t < 32; ++t) { const float xn = bf2f(cp[132 * (t + 2)]); vv[t] = silu_fast(w0 * xm + w1 * xc + w2 * xn); xm = xc; xc = xn; }
#pragma unroll
                for (int hp = 0; hp < 2; ++hp) { unsigned pk[8];
#pragma unroll
                    for (int q = 0; q < 8; ++q) { const int r0 = 2 * q, r1 = 2 * q + 1; pk[q] = pkc(vv[(r0 & 3) + 8 * (r0 >> 2) + 4 * hp], vv[(r1 & 3) + 8 * (r1 >> 2) + 4 * hp]); }
                    bf16* dst = VA + (size_t)((d >> 5) * 2 + I) * 1024 + ((d & 31) + 32 * hp) * 8;
                    *(v4u*)dst = (v4u){pk[0], pk[1], pk[2], pk[3]}; *(v4u*)(dst + 512) = (v4u){pk[4], pk[5], pk[6], pk[7]}; }
            }
            asm volatile("s_waitcnt lgkmcnt(0)" ::: "memory");
        }
    }
}

template <int DM>
__device__ __forceinline__ void dn_prep_item(Frame& F, int item) {
    const int g = item >> 2, h = item & 3, lane = opaque(F.lane), r32 = lane & 31, hh = lane >> 5;
    const int m0 = 64 * g;
    int L, p0; if (m0 < TP) { L = L_P; p0 = m0 & (L_P - 1); } else { L = L_S; p0 = (m0 - TP) & (L_S - 1); }
    const bf16* raw = (const bf16*)(F.ws + WS_QKV);
    const float* cw = F.in[I_DNCONVW];
    const size_t gh = (size_t)g * NH + h;
    bf16* KA = (bf16*)(F.ws + WS_KA) + gh * 8192; bf16* QA = (bf16*)(F.ws + WS_QA) + gh * 8192; bf16* KTA = (bf16*)(F.ws + WS_KTA) + gh * 8192;
    const bool v_first = !(F.wave & 1);
    if (v_first) prep_v_images<DM>(F, raw, cw, m0, p0, L, h, gh, lane);
    bf16x8 kf[2][8];
    LAS unsigned char* sl = F.lds + F.wave * 16384;
#pragma unroll
    for (int I = 0; I < 2; ++I) { const int tok = 32 * I + r32;
        load_norm_tile(raw, cw, sl, m0, p0, L, 32 * I, 512 + 128 * h, lane, 1.0f, kf[I]);
        { char* kab = (char*)KA + (size_t)I * 8192; const unsigned lo16 = (unsigned)lane * 16u;
#pragma unroll
          for (int ks = 0; ks < 8; ++ks) *(bf16x8*)(kab + lo16 + ks * 1024) = kf[I][ks]; }
        if constexpr (!(DM & 8)) { const int x = tok & 15, hp = (x >> 2) & 1, jp = 4 * (x >> 3) + (x & 3), kl = (tok >> 4) & 1;
          LAS unsigned char* img = sl + (unsigned)(((kl * 64 + 4 * hh + 32 * hp) * 8 + jp) * 2);
#pragma unroll
          for (int ks = 0; ks < 8; ++ks) {
#pragma unroll
            for (int j = 0; j < 8; ++j) *(LAS unsigned short*)(img + (ks >> 1) * 2048 + (16 * (ks & 1) + 8 * (j >> 2) + (j & 3)) * 16) = (unsigned short)kf[I][ks][j]; }
          v4u pc[8];
#pragma unroll
          for (int i = 0; i < 8; ++i) pc[i] = *(const LAS v4u*)(sl + i * 1024 + lane * 16);
#pragma unroll
          for (int i = 0; i < 8; ++i) *(v4u*)((char*)KTA + (size_t)(((i >> 1) * 4 + 2 * I + (i & 1)) * 1024) + lane * 16) = pc[i];
          __builtin_amdgcn_sched_barrier(0); }

    }
    const float* gsc = (const float*)(F.ws + WS_GSC);
    const size_t mrow = (size_t)(m0 + lane) * 4 + h;
    const float gf = gsc[mrow], bfw = gsc[(size_t)T * 4 + mrow], gb = gsc[(size_t)2 * T * 4 + mrow], bbw = gsc[(size_t)3 * T * 4 + mrow];
    float gcf = gf, pb = gb;
#pragma unroll
    for (int o = 1; o < 64; o <<= 1) { const float y = __shfl_up(gcf, o), y2 = __shfl_up(pb, o); if (lane >= o) { gcf += y; pb += y2; } }
    const float gcb = rdlane(pb, 63) - pb + gb;
    float* SC = (float*)(F.ws + WS_SC) + gh * 384;
    { const float glf = rdlane(gcf, 63), glb = rdlane(gcb, 0);
      SC[lane] = __expf(gcf); SC[64 + lane] = __expf(glf - gcf); if (lane == 0) SC[128] = __expf(glf);
      SC[192 + lane] = __expf(gcb); SC[256 + lane] = __expf(glb - gcb); if (lane == 0) SC[320] = __expf(glb); }
    LAS float* stw = (LAS float*)(F.lds + F.wave * 16384);
    LAS float* stash = stw + lane;
    {
        bf16x8 qf[2][8];
#pragma unroll
        for (int Ic = 0; Ic < 2; ++Ic) {
            load_norm_tile(raw, cw, sl, m0, p0, L, 32 * Ic, 128 * h, lane, 0.08838834764831845f, qf[Ic]);
            { char* qab = (char*)QA + (size_t)Ic * 8192; const unsigned lo16 = (unsigned)lane * 16u;
#pragma unroll
              for (int ks = 0; ks < 8; ++ks) *(bf16x8*)(qab + lo16 + ks * 1024) = qf[Ic][ks]; }
            __builtin_amdgcn_sched_barrier(0); }
#pragma unroll
        for (int Ic = 0; Ic < 2; ++Ic) {
#pragma unroll
            for (int Jr = 0; Jr < 2; ++Jr) { f32x16 a = {0};
#pragma unroll
                for (int ks = 0; ks < 8; ++ks) a = MFMA32(kf[Jr][ks], qf[Ic][ks], a);
#pragma unroll
                for (int r = 0; r < 16; ++r) stw[(32 * Jr + (r & 3) + 8 * (r >> 2) + 4 * hh) * 64 + 32 * Ic + r32] = a[r]; }
            __builtin_amdgcn_sched_barrier(0); }
        float M[64];
        if constexpr (DM & 1) { const int l1 = opaque(lane);
#pragma unroll
            for (int j = 0; j < 64; ++j) { const float dec = __expf(fminf(gcf - rdlane(gcf, j), 0.f)); const float kv = stash[j * 64] * dec; M[j] = l1 >= j ? kv : 0.f; __builtin_amdgcn_sched_barrier(0); }
            store_rows_as_afrags(M, (bf16*)(F.ws + WS_QKAF) + gh * 4096, lane); }
        if constexpr (DM & 2) { const int l2 = opaque(lane);
#pragma unroll
            for (int j = 0; j < 64; ++j) { const float dec = __expf(fminf(gcb - rdlane(gcb, j), 0.f)); const float kv = stash[j * 64] * dec; M[j] = l2 <= j ? kv : 0.f; __builtin_amdgcn_sched_barrier(0); }
            store_rows_as_afrags(M, (bf16*)(F.ws + WS_QKAB) + gh * 4096, lane); }
    }
    __builtin_amdgcn_sched_barrier(0);
    float Lf[64];
    {
#pragma unroll
        for (int Ic = 0; Ic < 2; ++Ic)
#pragma unroll
            for (int Jr = 0; Jr < 2; ++Jr) { f32x16 a = {0};
#pragma unroll
                for (int ks = 0; ks < 8; ++ks) a = MFMA32(kf[Jr][ks], kf[Ic][ks], a);
#pragma unroll
                for (int r = 0; r < 16; ++r) stw[(32 * Jr + (r & 3) + 8 * (r >> 2) + 4 * hh) * 64 + 32 * Ic + r32] = a[r]; }
        __builtin_amdgcn_sched_barrier(0);
        if constexpr (DM & 1) { const int l3 = opaque(lane); const float gcf3 = opaquef(gcf);
#pragma unroll
            for (int j = 0; j < 64; ++j) { const float df = __expf(fminf(gcf3 - rdlane(gcf3, j), 0.f));
                const float kv = bfw * stash[j * 64] * df; Lf[j] = l3 > j ? kv : 0.f; __builtin_amdgcn_sched_barrier(0); } }
    }
    if constexpr (DM & 1) {
        float M[64]; const int l4 = opaque(lane);
        M[63] = l4 == 63 ? 1.f : 0.f;
        subst_fwd<(DM & 16) != 0>(M, Lf, l4);
#pragma unroll
        for (int j = 0; j < 64; ++j) { M[j] *= rdlane(bfw, j); if ((j & 7) == 7) __builtin_amdgcn_sched_barrier(0); }
        store_rows_as_afrags(M, (bf16*)(F.ws + WS_TAF) + gh * 4096, lane);
    }
    __builtin_amdgcn_sched_barrier(0);
    if constexpr (DM & 2) {
        float M[64]; const int l5 = opaque(lane);
        M[0] = l5 == 0 ? 1.f : 0.f;
        subst_bwd<(DM & 16) != 0>(M, stash, bbw, opaquef(gcb), l5);
#pragma unroll
        for (int j = 0; j < 64; ++j) { M[j] *= rdlane(bbw, j); if ((j & 7) == 7) __builtin_amdgcn_sched_barrier(0); }
        store_rows_as_afrags(M, (bf16*)(F.ws + WS_TAB) + gh * 4096, lane);
    }
    if (!v_first) prep_v_images<DM>(F, raw, cw, m0, p0, L, h, gh, lane);
}

constexpr int SB_KA = 0, SB_QA = 16384, SB_KTA = 32768, SB_V = 49152, SB_TA = 65536, SB_QKA = 71680, SB_SC = 77824, SB_BYTES = 78592;
static_assert(2 * SB_BYTES <= LDSCTL_OFF, "scan buffers vs LDS control words");
__device__ __forceinline__ bf16x8 packB(const f32x16& x, int sh) {
    v4u p; p.x = pkc(x[8 * sh + 0], x[8 * sh + 1]); p.y = pkc(x[8 * sh + 2], x[8 * sh + 3]); p.z = pkc(x[8 * sh + 4], x[8 * sh + 5]); p.w = pkc(x[8 * sh + 6], x[8 * sh + 7]);
    return __builtin_bit_cast(bf16x8, p);
}
__device__ __forceinline__ void lds_rows16(const LAS float* base, int hh, float (&o)[16]) {
#pragma unroll
    for (int q = 0; q < 4; ++q) { const f32x4 v = *(const LAS f32x4*)(base + 8 * q + 4 * hh); o[4 * q] = v.x; o[4 * q + 1] = v.y; o[4 * q + 2] = v.z; o[4 * q + 3] = v.w; }
}
#define GLDS16(gsrc, ldst) __builtin_amdgcn_global_load_lds((const unsigned*)(gsrc), (LAS unsigned*)(ldst), 16, 0, 0)
#define GLDS4(gsrc, ldst) __builtin_amdgcn_global_load_lds((const unsigned*)(gsrc), (LAS unsigned*)(ldst), 4, 0, 0)
#ifndef SCAN_WARM
#define SCAN_WARM 0
#endif
constexpr int NLOAD = SCAN_WARM ? 3 : 4;
constexpr int SB_SINK = 2 * SB_BYTES;
static_assert(SB_SINK + 256 <= LDSCTL_OFF, "scan sink vs LDS control words");
template <int DIR, int P>
__device__ __forceinline__ void scan_piece(Frame& F, size_t gh, LAS unsigned char* B, unsigned lo16) {
    if constexpr (P < 16) GLDS16(F.ws + WS_KA + gh * 16384 + lo16 + P * 1024, B + SB_KA + P * 1024);
    else if constexpr (P < 32) GLDS16(F.ws + WS_QA + gh * 16384 + lo16 + (P - 16) * 1024, B + SB_QA + (P - 16) * 1024);
    else if constexpr (P < 48) GLDS16(F.ws + WS_KTA + gh * 16384 + lo16 + (P - 32) * 1024, B + SB_KTA + (P - 32) * 1024);
    else if constexpr (P < 64) GLDS16(F.ws + WS_VACC + gh * 16384 + lo16 + (P - 48) * 1024, B + SB_V + (P - 48) * 1024);
    else if constexpr (P < 70) { constexpr int slot = P - 64, fr = DIR ? (slot < 4 ? slot : slot + 2) : (slot < 2 ? slot : slot + 2); GLDS16(F.ws + (DIR ? WS_TAB : WS_TAF) + gh * 8192 + lo16 + fr * 1024, B + SB_TA + slot * 1024); }
    else if constexpr (P < 76) { constexpr int slot = P - 70, fr = DIR ? (slot < 4 ? slot : slot + 2) : (slot < 2 ? slot : slot + 2); GLDS16(F.ws + (DIR ? WS_QKAB : WS_QKAF) + gh * 8192 + lo16 + fr * 1024, B + SB_QKA + slot * 1024); }
    else { if (F.lane < 48) GLDS16(F.ws + WS_SC + (gh * 384 + DIR * 192) * 4 + lo16, B + SB_SC); }
}
template <int DIR, int LW, int P = LW>
__device__ __forceinline__ void scan_fill_lw(Frame& F, size_t gh, LAS unsigned char* B, unsigned lo16) {
    if constexpr (P < 77) { scan_piece<DIR, P>(F, gh, B, lo16); scan_fill_lw<DIR, LW, P + NLOAD>(F, gh, B, lo16); }
}
template <int DIR>
__device__ __forceinline__ void scan_fill(Frame& F, int lw, size_t gh, int buf) {
    const unsigned lo16 = (unsigned)F.lane * 16u;
    LAS unsigned char* B = F.lds + buf * SB_BYTES;
    if (lw == 0) scan_fill_lw<DIR, 0>(F, gh, B, lo16); else if (lw == 1) scan_fill_lw<DIR, 1>(F, gh, B, lo16); else if (lw == 2 || NLOAD == 3) scan_fill_lw<DIR, 2>(F, gh, B, lo16); else scan_fill_lw<DIR, 3>(F, gh, B, lo16);
}
template <int DIR>
__device__ __forceinline__ void scan_warm(Frame& F, size_t gh) {
    const unsigned l128 = (unsigned)F.lane * 128u; LAS unsigned char* sink = F.lds + SB_SINK;
#pragma unroll
    for (int i = 0; i < 2; ++i) { GLDS4(F.ws + WS_KA + gh * 16384 + i * 8192 + l128, sink); GLDS4(F.ws + WS_QA + gh * 16384 + i * 8192 + l128, sink);
        GLDS4(F.ws + WS_KTA + gh * 16384 + i * 8192 + l128, sink); GLDS4(F.ws + WS_VACC + gh * 16384 + i * 8192 + l128, sink); }
    GLDS4(F.ws + (DIR ? WS_TAB : WS_TAF) + gh * 8192 + l128, sink); GLDS4(F.ws + (DIR ? WS_QKAB : WS_QKAF) + gh * 8192 + l128, sink);
    if (F.lane < 6) GLDS4(F.ws + WS_SC + (gh * 384 + DIR * 192) * 4 + l128, sink);
}
#define SCAN_BAR() do { asm volatile("" ::: "memory"); __builtin_amdgcn_s_barrier(); asm volatile("" ::: "memory"); } while (0)
#define SCAN_LOADER_WAIT() asm volatile("s_waitcnt vmcnt(0)" ::: "memory")
template <int DIR>
__device__ __forceinline__ void dn_scan_block(Frame& F, int set, int b, int h) {
    const int N = set ? L_S / 64 : L_P / 64, g0 = set ? TP / 64 + b * (L_S / 64) : b * (L_P / 64);
    const int w = F.wave & 3;
    const bool loader = F.wave >= 4, warmer = SCAN_WARM && F.wave == 7;
    constexpr int AHEAD = 3;
#define GH_(st) ((size_t)(g0 + (DIR ? N - 1 - (st) : (st))) * NH + h)
#ifndef SCAN_REPS
#define SCAN_REPS 1
#endif
    f32x16 s[4];
#pragma unroll 1
    for (int rep__ = 0; rep__ < SCAN_REPS; ++rep__) {
#ifndef SCAN_PROBE
#define SCAN_PROBE 0
#endif
    const bool real__ = rep__ == SCAN_REPS - 1;
    const int lane = opaque(F.lane), r32 = lane & 31, hh = lane >> 5;
    if (warmer) { for (int st = 1; st < AHEAD && st < N; ++st) scan_warm<DIR>(F, GH_(st)); }
    else if (loader) { scan_fill<DIR>(F, w, GH_(0), 0); SCAN_LOADER_WAIT(); }
    else {
        if (set) { const float* s0 = (DIR ? F.in[I_SB] : F.in[I_SF]) + (size_t)(b * NH + h) * 128 * 128 + 32 * w + r32;
#pragma unroll
            for (int dt = 0; dt < 4; ++dt)
#pragma unroll
                for (int r = 0; r < 16; ++r) s[dt][r] = s0[(size_t)(32 * dt + crow(r, hh)) * 128];
        } else {
#pragma unroll
            for (int dt = 0; dt < 4; ++dt)
#pragma unroll
                for (int r = 0; r < 16; ++r) s[dt][r] = 0.f;
        }
    }
    SCAN_BAR();
#pragma unroll 1
    for (int step = 0; step < N; ++step) {
        const int n = DIR ? N - 1 - step : step;
        if (warmer) { if (step + AHEAD < N) scan_warm<DIR>(F, GH_(step + AHEAD)); }
        else if (loader) { if (step + 1 < N && (real__ || SCAN_PROBE != 1)) scan_fill<DIR>(F, w, GH_(step + 1), (step + 1) & 1); SCAN_LOADER_WAIT(); }
        else if (real__ || SCAN_PROBE != 2) {
            const LAS unsigned char* B = F.lds + (step & 1) * SB_BYTES;
            const unsigned lo16 = (unsigned)lane * 16u;
#define FR_(off, f) (*(const LAS bf16x8*)(B + (off) + lo16 + (f) * 1024))
            bf16x8 sB[4][2];
#pragma unroll
            for (int dt = 0; dt < 4; ++dt) { sB[dt][0] = packB(s[dt], 0); sB[dt][1] = packB(s[dt], 1); }
            f32x16 P[2], Oa[2];
            {
                constexpr int DEPTH = 4;
                bf16x8 win[DEPTH];
#define S1_OFF(i) ((((i) >> 4) ? SB_QA : SB_KA) + (((((i) >> 3) & 1) * 8 + ((i) & 7)) * 1024))
#pragma unroll
                for (int i = 0; i < DEPTH; ++i) win[i] = *(const LAS bf16x8*)(B + S1_OFF(i) + lo16);
                f32x16 acc4[2][2];
#pragma unroll
                for (int I = 0; I < 2; ++I) { acc4[I][0] = (f32x16){0}; acc4[I][1] = (f32x16){0}; }
#pragma unroll
                for (int i = 0; i < 32; ++i) { const int kq = i >> 4, I = (i >> 3) & 1, ks = i & 7;
                    acc4[I][kq] = MFMA32(win[i % DEPTH], sB[ks >> 1][ks & 1], acc4[I][kq]);
                    if (i + DEPTH < 32) win[i % DEPTH] = *(const LAS bf16x8*)(B + S1_OFF(i + DEPTH) + lo16); }
#undef S1_OFF
                P[0] = acc4[0][0]; Oa[0] = acc4[0][1]; P[1] = acc4[1][0]; Oa[1] = acc4[1][1];
                __builtin_amdgcn_sched_group_barrier(0x100, DEPTH, 0);
#pragma unroll
                for (int i = 0; i < 32 - DEPTH; ++i) { __builtin_amdgcn_sched_group_barrier(0x008, 1, 0); __builtin_amdgcn_sched_group_barrier(0x100, 1, 0); }
                __builtin_amdgcn_sched_group_barrier(0x008, DEPTH, 0);
            }
            const LAS float* SC = (const LAS float*)(B + SB_SC);
            bf16x8 inB[2][2];
#pragma unroll
            for (int I = 0; I < 2; ++I) { float eg[16]; lds_rows16(SC + 32 * I, hh, eg);
                const v4u v0 = *(const LAS v4u*)(B + SB_V + w * 4096 + I * 2048 + lane * 16), v1 = *(const LAS v4u*)(B + SB_V + w * 4096 + I * 2048 + 1024 + lane * 16);
                const unsigned vw[8] = {v0.x, v0.y, v0.z, v0.w, v1.x, v1.y, v1.z, v1.w};
#pragma unroll
                for (int r = 0; r < 16; ++r) { const float vv = (r & 1) ? bfhi(vw[r >> 1]) : bflo(vw[r >> 1]); P[I][r] = vv - eg[r] * P[I][r]; Oa[I][r] *= eg[r]; }
                inB[I][0] = packB(P[I], 0); inB[I][1] = packB(P[I], 1); }
            f32x16 V[2];
#pragma unroll
            for (int Ip = 0; Ip < 2; ++Ip) { f32x16 a = {0};
#pragma unroll
                for (int ks = 0; ks < 4; ++ks) if (DIR ? (Ip == 0 || ks >= 2) : (Ip == 1 || ks < 2)) a = MFMA32(FR_(SB_TA, Ip ? 2 + ks : ks), inB[ks >> 1][ks & 1], a);
                V[Ip] = a; }
            bf16x8 vB[2][2], vsB[2][2];
#pragma unroll
            for (int I = 0; I < 2; ++I) { float egl[16]; lds_rows16(SC + 64 + 32 * I, hh, egl);
                vB[I][0] = packB(V[I], 0); vB[I][1] = packB(V[I], 1);
#pragma unroll
                for (int r = 0; r < 16; ++r) V[I][r] *= egl[r];
                vsB[I][0] = packB(V[I], 0); vsB[I][1] = packB(V[I], 1); }
            unsigned char* Ob = F.ws + o_off(DIR, g0 + n) + (size_t)h * 16384 + w * 4096 + lane * 16;
#pragma unroll
            for (int Ip = 0; Ip < 2; ++Ip) {
#pragma unroll
                for (int ks = 0; ks < 4; ++ks) if (DIR ? (Ip == 0 || ks >= 2) : (Ip == 1 || ks < 2)) Oa[Ip] = MFMA32(FR_(SB_QKA, Ip ? 2 + ks : ks), vB[ks >> 1][ks & 1], Oa[Ip]);
                v4u o0, o1;
                o0.x = pkc(Oa[Ip][0], Oa[Ip][1]); o0.y = pkc(Oa[Ip][2], Oa[Ip][3]); o0.z = pkc(Oa[Ip][4], Oa[Ip][5]); o0.w = pkc(Oa[Ip][6], Oa[Ip][7]);
                o1.x = pkc(Oa[Ip][8], Oa[Ip][9]); o1.y = pkc(Oa[Ip][10], Oa[Ip][11]); o1.z = pkc(Oa[Ip][12], Oa[Ip][13]); o1.w = pkc(Oa[Ip][14], Oa[Ip][15]);
                *(v4u*)(Ob + Ip * 2048) = o0; *(v4u*)(Ob + Ip * 2048 + 1024) = o1; }
            const float gl = SC[128];
#pragma unroll
            for (int dt = 0; dt < 4; ++dt) { f32x16 a = s[dt] * gl;
                bf16x8 ft[4];
#pragma unroll
                for (int ks = 0; ks < 4; ++ks) ft[ks] = FR_(SB_KTA, dt * 4 + ks);
#pragma unroll
                for (int ks = 0; ks < 4; ++ks) a = MFMA32(ft[ks], vsB[ks >> 1][ks & 1], a);
                s[dt] = a; }
#undef FR_
        }
        SCAN_BAR();
    }
    }
    if (warmer) SCAN_LOADER_WAIT();
#undef GH_
    const int lane = F.lane, r32 = lane & 31, hh = lane >> 5;
    if (!loader && !set) { float* so = F.out + (size_t)T * D + (size_t)DIR * (NB_P * NH * 128 * 128) + (size_t)(b * NH + h) * 128 * 128 + 32 * w + r32;
#pragma unroll
        for (int dt = 0; dt < 4; ++dt)
#pragma unroll
            for (int r = 0; r < 16; ++r) so[(size_t)(32 * dt + crow(r, hh)) * 128] = s[dt][r]; }
}
__device__ __forceinline__ void dn_scan_phase(Frame& F) {
    const int bx = blockIdx.x;
    if (bx >= 192) return;
    int set, b, h, dir;
    if (bx < 64) { set = 1; b = bx >> 3; h = (bx >> 1) & 3; dir = bx & 1; } else { const int r = bx - 64; set = 0; b = r >> 3; h = (r >> 1) & 3; dir = r & 1;
        if (F.wave < 4) { const int item = ((b * (L_P / 64) + F.wave) * NH) + h; if (dir) dn_prep_item<2>(F, item); else dn_prep_item<1>(F, item); }
        asm volatile("s_waitcnt vmcnt(0)" ::: "memory"); __syncthreads(); }
    if (dir) dn_scan_block<1>(F, set, b, h); else dn_scan_block<0>(F, set, b, h);
}
__device__ __forceinline__ void conv_rows_queue(Frame& F) {
    const int lane = F.lane;
    const bf16* CB = (const bf16*)(F.ws + WS_CB); const bf16* UC = (const bf16*)(F.ws + WS_UC); bf16* YC = (bf16*)(F.ws + WS_YC);
    const float* cw = F.in[I_CONVW];
    float w0[8], w1[8], w2[8];
#pragma unroll
    for (int e = 0; e < 8; ++e) { w0[e] = cw[8 * lane + e]; w1[e] = cw[512 + 8 * lane + e]; w2[e] = cw[1024 + 8 * lane + e]; }
    for (;;) { const int mb = q_take(F.ctl + CW_Q_CONV, 16u, lane); if (mb >= T) break;
#pragma unroll 4
        for (int m = mb; m < mb + 16; ++m) {
            int p, dd, L;
            if (m < TP) { p = m & 255; dd = 1; L = 256; } else { p = (m - TP) & 4095; dd = 64; L = 4096; }
            const v4u z4 = {0u, 0u, 0u, 0u};
            const v4u c4 = *(const v4u*)(CB + (size_t)m * 512 + 8 * lane);
            const v4u u1 = *(const v4u*)(UC + (size_t)m * 512 + 8 * lane);
            const v4u u0 = p - dd >= 0 ? *(const v4u*)(UC + (size_t)(m - dd) * 512 + 8 * lane) : z4;
            const v4u u2 = p + dd < L ? *(const v4u*)(UC + (size_t)(m + dd) * 512 + 8 * lane) : z4;
            v4u y;
#pragma unroll
            for (int q = 0; q < 4; ++q) {
                const float lo = bflo(c4[q]) * (w0[2 * q] * bflo(u0[q]) + w1[2 * q] * bflo(u1[q]) + w2[2 * q] * bflo(u2[q]));
                const float hi = bfhi(c4[q]) * (w0[2 * q + 1] * bfhi(u0[q]) + w1[2 * q + 1] * bfhi(u1[q]) + w2[2 * q + 1] * bfhi(u2[q]));
                y[q] = pk2(lo, hi); }
            *(v4u*)(YC + (size_t)m * 512 + 8 * lane) = y;
        }
    }
}
__device__ __forceinline__ void post_phase(Frame& F) {
    const int gw = F.vcu * NWAVES + F.wave, NGW = F.G * NWAVES, lane = F.lane;
    const unsigned char* SZ = F.ws + WS_SZ; unsigned char* YD = F.ws + WS_YD;
    const float* dnn = F.in[I_DNNORM];
    const int r32 = lane & 31, hh = lane >> 5;
    LAS unsigned char* tile = F.lds + F.wave * 16384;
    float gn[4];
#pragma unroll
    for (int w = 0; w < 4; ++w) gn[w] = dnn[32 * w + r32];
    const int trow = lane >> 4, tcol = (lane & 15) * 16;
    constexpr int NIT = NCHUNK * NH * 2;
    const int nfull = NIT / NGW, rem = NIT - nfull * NGW;
#pragma unroll 1
    for (int k = 0; k <= nfull; ++k) {
        int it;
        if (k < nfull) it = gw + k * NGW; else { const int j = F.wave * F.G + F.vcu; if (j >= rem) break; it = nfull * NGW + j; }
        const int I = it & 1, h = (it >> 1) & 3, g = it >> 3;
        const size_t rowbase = ((size_t)g * 64 + 32 * I) * 1024 + 256 * h;
        v4u zz[8];
#pragma unroll
        for (int i = 0; i < 8; ++i) zz[i] = *(const v4u*)(SZ + rowbase + (size_t)(trow + 4 * i) * 1024 + tcol);
        const unsigned char* of = F.ws + o_off(0, g) + (size_t)h * 16384 + I * 2048 + lane * 16;
        const unsigned char* ob = F.ws + o_off(1, g) + (size_t)h * 16384 + I * 2048 + lane * 16;
        float o[4][16]; float ss[16];
#pragma unroll
        for (int r = 0; r < 16; ++r) ss[r] = 0.f;
#pragma unroll
        for (int w = 0; w < 4; ++w) { const v4u a0 = *(const v4u*)(of + w * 4096), a1 = *(const v4u*)(of + w * 4096 + 1024), b0 = *(const v4u*)(ob + w * 4096), b1 = *(const v4u*)(ob + w * 4096 + 1024);
            const unsigned aw[8] = {a0.x, a0.y, a0.z, a0.w, a1.x, a1.y, a1.z, a1.w}, bw[8] = {b0.x, b0.y, b0.z, b0.w, b1.x, b1.y, b1.z, b1.w};
#pragma unroll
            for (int r = 0; r < 16; ++r) { const float v = (r & 1) ? bfhi(aw[r >> 1]) + bfhi(bw[r >> 1]) : bflo(aw[r >> 1]) + bflo(bw[r >> 1]); o[w][r] = v; ss[r] += v * v; } }
#pragma unroll
        for (int i = 0; i < 8; ++i) *(LAS v4u*)(tile + (trow + 4 * i) * 264 + tcol) = zz[i];
#pragma unroll
        for (int r = 0; r < 16; ++r) { float t = ss[r]; t += __shfl_xor(t, 1); t += __shfl_xor(t, 2); t += __shfl_xor(t, 4); t += __shfl_xor(t, 8); t += __shfl_xor(t, 16); ss[r] = 1.0f / sqrtf(t * (1.f / 128.f) + EPS); }
#pragma unroll
        for (int r = 0; r < 16; ++r) { LAS unsigned short* rowp = (LAS unsigned short*)(tile + ((r & 3) + 8 * (r >> 2) + 4 * hh) * 264) + r32;
#pragma unroll
            for (int w = 0; w < 4; ++w) { const float z = bf2f(rowp[32 * w]); rowp[32 * w] = (unsigned short)f2bf(o[w][r] * ss[r] * gn[w] * z); } }
#pragma unroll
        for (int i = 0; i < 8; ++i) zz[i] = *(const LAS v4u*)(tile + (trow + 4 * i) * 264 + tcol);
#pragma unroll
        for (int i = 0; i < 8; ++i) *(v4u*)(YD + rowbase + (size_t)(trow + 4 * i) * 1024 + tcol) = zz[i];
    }
}

struct Args { const float* in[23]; float* out; unsigned char* ws; int ph_lo, ph_hi; };
__global__ void __launch_bounds__(NWAVES * 64, 2) mk_fwd(Args args) {
    extern __shared__ __attribute__((aligned(16))) unsigned char lds[];
    Frame F;
    F.lds = (LAS unsigned char*)lds;
    F.MISC = (volatile LAS unsigned*)(F.lds + MISC_OFF);
    F.tid = threadIdx.x; F.lane = F.tid & 63; F.wave = __builtin_amdgcn_readfirstlane(F.tid >> 6);
    F.G = gridDim.x; { const int bx = blockIdx.x; F.vcu = (F.G % 8 == 0) ? (bx % 8) * (F.G / 8) + bx / 8 : bx; }
    unsigned char* ws = args.ws; F.ws = ws; F.out = args.out;
    F.in = args.in;
    F.ctl = (gu32*)(ws + WS_CTL);
    for (int u = F.tid; u < (LDS_BYTES - LDSCTL_OFF) / 4; u += NWAVES * 64) ((LAS unsigned*)(F.lds + LDSCTL_OFF))[u] = 0u;
    __syncthreads();
    XcdBarrier bar; bar.bar = (unsigned*)(F.ctl + CW_BAR); bar.x = 0; bar.st = nullptr;
    const int lo = args.ph_lo, hi = args.ph_hi;
    if (hi - lo > 1) bar = xcd_barrier_post((unsigned*)(F.ctl + CW_BAR), F.MISC + 8);
    F.xcc = xb_xcc_id();
    if (F.tid == 0 && blockIdx.x < 192) __hip_atomic_fetch_add(F.ctl + CW_ECNT + 64 * F.xcc, 1u, RLX_AGENT);
#ifndef PH_MASK
#define PH_MASK 0xFFFF
#endif
#define IN(k) ((((PH_MASK) >> (k)) & 1) && lo <= (k) && (k) < hi)
#define SEAM(k) do { if (IN(k) && IN((k) + 1)) xcd_barrier(bar); } while (0)
#ifndef DUP_MASK
#define DUP_MASK 0
#endif
#define NREP(k) ((((DUP_MASK) >> (k)) & 1) ? 2 : 1)
#define REPB(k) _Pragma("unroll") for (int rep_ = 0; rep_ < NREP(k); ++rep_) { if (rep_) xcd_barrier(bar);
#define REPE }
    const float* mod = (const float*)(ws + WS_MOD);
    bf16* H = (bf16*)(ws + WS_H); bf16* ACT = (bf16*)(ws + WS_ACT);

    if (IN(0)) { REPB(0)  p0_prologue(F); REPE } SEAM(0);
#ifdef EXTRA_BARS
    for (int eb = 0; eb < EXTRA_BARS; ++eb) xcd_barrier(bar);
#endif
    if (IN(1)) { REPB(1)  norm_phase<0>(F, F.in[I_XP], F.in[I_XS], F.in[I_NF1], 0 * D, 1 * D, H); REPE } SEAM(1);
    if (IN(2)) { REPB(2)  pg8::Gemm g{H, (const bf16*)(ws + WS_WF1I), T, NFFI, D, D, H, 1 << 30}; pg8::StaticOrder S; S.init(T, NFFI, F.G, (int)blockIdx.x);
        pg8::EpiSwiglu E{ACT, FF}; pg8::gemm_phase<pg8::EpiSwiglu, pg8::StaticOrder, SWIGLU_ALIGN, GEMM_SP2>(F.lds + RING_OFF, g, S, E);
#if W2_IN_P0 == 2
        { constexpr int NLAST = (T / 256) * (NFFI / 256) - 12 * 256;
          if ((int)blockIdx.x >= NLAST && F.G == 256) ffn2_weights_static(F, (LAS float*)(F.lds + F.wave * 16384), ((int)blockIdx.x - NLAST) * NWAVES + F.wave, (256 - NLAST) * NWAVES); }
#endif
    REPE } SEAM(2);
    if (IN(3)) { pg8::Gemm g{ACT, (const bf16*)(ws + WS_WF1O), T, D, FF, FF, ACT, 1 << 30}; pg8::SplitOrder S; S.init(T, D, F.G, (int)blockIdx.x, 96 * 256, 192);
        pg8::EpiResid<false, true> E{F.in[I_XP], F.in[I_XS], TP, F.out, D, mod + 2 * D, NMOD, 0.5f}; pg8::gemm_phase<pg8::EpiResid<false, true>, pg8::SplitOrder, RESID_ALIGN, GEMM_SP2>(F.lds + RING_OFF, g, S, E);
        if (blockIdx.x < 192) { xcd_publish(F, F.ctl + CW_XPUB + 0 * 1024, __hip_atomic_load(F.ctl + CW_ECNT + 64 * F.xcc, RLX_AGENT), F.ctl + CW_EDONE + 64 * 0); panel_wait(F, F.ctl + CW_EDONE + 64 * 0, 192u); }
        if (blockIdx.x < 192) norm_rows<1, true>(F, F.out, (const bf16*)F.out + (size_t)TP * D, F.in[I_NMIX], 3 * D, 4 * D, H, 0, 96 * 256, (int)blockIdx.x * NWAVES + F.wave, 192 * NWAVES, 16, nullptr); } SEAM(3);
    if (IN(4)) { norm_rows<1, true>(F, F.out, (const bf16*)F.out + (size_t)TP * D, F.in[I_NMIX], 3 * D, 4 * D, H, NOSHADOW ? 0 : 96 * 256, T, F.vcu * NWAVES + F.wave, F.G * NWAVES, 1, nullptr, blockIdx.x >= 192 || !IN(3));        if (IN(5)) xcd_publish(F, F.ctl + CW_XPUB + 3 * 1024, F.MISC[8], F.ctl + CW_TAIL2); else {} }
    if (IN(5)) { REPB(5)  pg8::Gemm g{H, (const bf16*)(ws + WS_WMI), T, NMIX, D, D, H, 1 << 30}; pg8::TwoStageOrder S; S.init(T, NMIX, F.G, (int)blockIdx.x, 96 * 256, (const unsigned*)(F.ctl + CW_TAIL2), IN(4) ? (unsigned)F.G : 0u);
        pg8::EpiMixIn E{(bf16*)(ws + WS_CB), (bf16*)(ws + WS_UC), (bf16*)(ws + WS_QKV), (bf16*)(ws + WS_SZ)}; pg8::gemm_phase<pg8::EpiMixIn, pg8::TwoStageOrder, true, GEMM_SP2>(F.lds + RING_OFF, g, S, E); REPE } SEAM(5);
    if (IN(6)) { REPB(6)  for (int it = (TP / 64) * NH + F.wave * F.G + (int)blockIdx.x; it < NCHUNK * NH; it += NWAVES * F.G) { if (rep_ + 1 < NREP(6)) dn_prep_item<PREP_PROBE_DM>(F, it); else dn_prep_item<3>(F, it); }
#if W2_IN_P0 == 0
        ffn2_weights_queue(F, (LAS float*)(F.lds + F.wave * 16384));
#endif
    REPE } SEAM(6);
    if (IN(7)) { REPB(7)
        dn_scan_phase(F);
#if CONV_IN_SCAN
        if (blockIdx.x >= 64) conv_rows_queue(F);
#endif
    REPE } SEAM(7);
    if (IN(8)) { REPB(8)
#if !CONV_IN_SCAN
        conv_rows_queue(F);
#endif
        post_phase(F); REPE } SEAM(8);
    if (IN(9)) { pg8::Gemm g{(const bf16*)(ws + WS_YC), (const bf16*)(ws + WS_WMO), T, D, D, 512, (const bf16*)(ws + WS_YD) - 8 * 64, 8}; pg8::SplitOrder S; S.init(T, D, F.G, (int)blockIdx.x, 96 * 256, 192);
        pg8::EpiResid<true, true> E{F.out, (const bf16*)F.out + (size_t)TP * D, TP, ws + WS_X2B, D, mod + 5 * D, NMOD, 1.0f}; pg8::gemm_phase<pg8::EpiResid<true, true>, pg8::SplitOrder, RESID_ALIGN, GEMM_SP2, true>(F.lds + RING_OFF, g, S, E);
        if (blockIdx.x < 192) { xcd_publish(F, F.ctl + CW_XPUB + 1 * 1024, __hip_atomic_load(F.ctl + CW_ECNT + 64 * F.xcc, RLX_AGENT), F.ctl + CW_EDONE + 64 * 1); panel_wait(F, F.ctl + CW_EDONE + 64 * 1, 192u); }
        norm_rows<0, true>(F, ws + WS_X2B, (const bf16*)(ws + WS_X2B) + (size_t)TP * D, F.in[I_NF2], 6 * D, 7 * D, (bf16*)(ws + WS_H3), 0, 96 * 256, NOSHADOW ? -1 : (blockIdx.x < 192 ? (int)blockIdx.x * NWAVES + F.wave : -1), 192 * NWAVES, 16, nullptr); } SEAM(9);
    if (IN(10)) { norm_rows<0, true>(F, ws + WS_X2B, (const bf16*)(ws + WS_X2B) + (size_t)TP * D, F.in[I_NF2], 6 * D, 7 * D, (bf16*)(ws + WS_H3), NOSHADOW ? 0 : 96 * 256, T, F.vcu * NWAVES + F.wave, F.G * NWAVES, 1, nullptr); if (IN(11)) xcd_publish(F, F.ctl + CW_XPUB + 4 * 1024, F.MISC[8], F.ctl + CW_TAIL3); else {} }
    if (IN(11)) { REPB(11)  pg8::Gemm g{(const bf16*)(ws + WS_H3), (const bf16*)(ws + WS_WF2I), T, NFFI, D, D, (const bf16*)(ws + WS_H3), 1 << 30}; pg8::TwoStageOrder S; S.init(T, NFFI, F.G, (int)blockIdx.x, 96 * 256, (const unsigned*)(F.ctl + CW_TAIL3), IN(10) ? (unsigned)F.G : 0u);
        pg8::EpiSwiglu E{ACT, FF}; pg8::gemm_phase<pg8::EpiSwiglu, pg8::TwoStageOrder, SWIGLU_ALIGN, GEMM_SP2>(F.lds + RING_OFF, g, S, E); REPE } SEAM(11);
    if (IN(12)) { pg8::Gemm g{ACT, (const bf16*)(ws + WS_WF2O), T, D, FF, FF, ACT, 1 << 30}; pg8::SplitOrder S; S.init(T, D, F.G, (int)blockIdx.x, 96 * 256, 192);
        pg8::EpiResid<true, true> E{ws + WS_X2B, (const bf16*)(ws + WS_X2B) + (size_t)TP * D, TP, ws + WS_X2B, D, mod + 8 * D, NMOD, 0.5f}; pg8::gemm_phase<pg8::EpiResid<true, true>, pg8::SplitOrder,        RESID_ALIGN, GEMM_SP2>(F.lds + RING_OFF, g, S, E);
        if (blockIdx.x < 192) { xcd_publish(F, F.ctl + CW_XPUB + 2 * 1024, __hip_atomic_load(F.ctl + CW_ECNT + 64 * F.xcc, RLX_AGENT), F.ctl + CW_EDONE + 64 * 2); panel_wait(F, F.ctl + CW_EDONE + 64 * 2, 192u); }
        norm_rows<2, true>(F, ws + WS_X2B, (const bf16*)(ws + WS_X2B) + (size_t)TP * D, F.in[I_NFIN], 0, 0, nullptr, 0, 96 * 256, NOSHADOW ? -1 : (blockIdx.x < 192 ? (int)blockIdx.x * NWAVES + F.wave : -1), 192 * NWAVES, 16, nullptr); } SEAM(12);
    if (IN(13)) { norm_rows<2, true>(F, ws + WS_X2B, (const bf16*)(ws + WS_X2B) + (size_t)TP * D, F.in[I_NFIN], 0, 0, nullptr, NOSHADOW ? 0 : 96 * 256, T, F.vcu * NWAVES + F.wave, F.G * NWAVES, 1, nullptr); }
#undef IN
#undef SEAM
}

extern "C" void kernel_launch(void* const* d_in, const int* in_sizes, int n_in, void* d_out, int out_size, void* d_ws, size_t ws_size, hipStream_t stream) {
    static int grid = 0;
    if (grid == 0) {
        if (n_in != 23 || ws_size < WS_END) { fprintf(stderr, "kernel_launch: need 23 inputs and >= %zu bytes of workspace; got n_in %d, ws %zu\n", (size_t)WS_END, n_in, ws_size); grid = -1; return; }
        int dev = 0, cus = 0, per_cu = 0;
        if (hipGetDevice(&dev) != hipSuccess || hipDeviceGetAttribute(&cus, hipDeviceAttributeMultiprocessorCount, dev) != hipSuccess) { grid = -1; return; }
        if (hipFuncSetAttribute((const void*)mk_fwd, hipFuncAttributeMaxDynamicSharedMemorySize, LDS_BYTES) != hipSuccess) { fprintf(stderr, "kernel_launch: hipFuncSetAttribute failed\n"); grid = -1; return; }
        if (hipOccupancyMaxActiveBlocksPerMultiprocessor(&per_cu, (const void*)mk_fwd, NWAVES * 64, LDS_BYTES) != hipSuccess || per_cu < 1) { fprintf(stderr, "kernel_launch: occupancy query says %d blocks per CU\n", per_cu); grid = -1; (void)hipGetLastError(); return; }
        grid = cus;
    }
    if (grid < 0) return;
    (void)hipMemsetAsync((char*)d_ws + WS_CTL, 0, CTL_ZERO_BYTES, stream);
    Args a{};
    for (int i = 0; i < 23; ++i) a.in[i] = (const float*)d_in[i];
    a.out = (float*)d_out; a.ws = (unsigned char*)d_ws;
#if MK_N_LAUNCHES == 1
    a.ph_lo = 0; a.ph_hi = N_PHASES;
    hipLaunchKernelGGL(mk_fwd, dim3(grid), dim3(NWAVES * 64), LDS_BYTES, stream, a);
#else
    for (int p = 0; p < N_PHASES; ++p) { a.ph_lo = p; a.ph_hi = p + 1; hipLaunchKernelGGL(mk_fwd, dim3(grid), dim3(NWAVES * 64), LDS_BYTES, stream, a); }
#endif
}
```

```cpp
#include <hip/hip_runtime.h>
#include <cstdio>
#include <cstdint>
#include <cmath>
namespace pg8 {
#define PG8_LAS __attribute__((address_space(3)))
typedef unsigned short bf16_t;
typedef short bf16x8 __attribute__((ext_vector_type(8)));
typedef float f32x4 __attribute__((ext_vector_type(4)));
typedef unsigned u32x4 __attribute__((ext_vector_type(4)));
constexpr int BM = 256, BK = 64, HALF = 128, HTB = HALF * BK * 2  , STAGE_BYTES = 8 * HTB, NXCD = 8, WGM = 8;

__host__ __device__ __forceinline__ int lds_byte(int r, int c) { const int st = (r >> 4) * 2 + (c >> 5), rr = r & 15, cc = c & 31, ob = rr * 64 + cc * 2; return st * 1024 + (ob ^ (((ob >> 9) & 1) << 5)); }
__host__ __device__ __forceinline__ void stage_rc(int b, int& R, int& C) { const int st = b / 1024, sb = b % 1024, swz = sb ^ (((sb >> 9) & 1) << 5); R = (st >> 1) * 16 + swz / 64; C = (st & 1) * 32 + (swz % 64) / 2; }
__host__ __device__ __forceinline__ int perm32(int rho) { const int n = rho >> 4, i = rho & 15; return 8 * (i >> 2) + 4 * n + (i & 3); }

struct Unit { int pm, pn; };
struct Gemm { const bf16_t* A; const bf16_t* Bt; int M, N, K; int lda; const bf16_t* A2; int ksplit; };

struct StaticOrder {
    int nM, nN, nwg, G, c;
    __host__ __device__ void init(int M, int N, int G_, int c_) { nM = M / BM; nN = N / BM; nwg = nM * nN; G = G_; c = c_; }
    __host__ __device__ bool next(int i, Unit& u) const {
        const long L = (long)i * G + c; if (L >= nwg) return false;
        int wgid = (int)L; { const int q = nwg / NXCD, r = nwg % NXCD, xcd = wgid % NXCD, off = wgid / NXCD; wgid = (xcd < r ? xcd * (q + 1) : r * (q + 1) + (xcd - r) * q) + off; }
        const int nig = WGM * nN, gid = wgid / nig, fm = gid * WGM, gsz = (nM - fm) < WGM ? (nM - fm) : WGM;
        u.pm = fm + ((wgid % nig) % gsz); u.pn = (wgid % nig) / gsz; return true;
    }
    __device__ __forceinline__ void a_ready(const Unit&) const {}
    __device__ __forceinline__ void done(const Unit&) const {}
};
struct SplitOrder : StaticOrder {
    int pm_off, wgm;
    __host__ __device__ void init(int M, int N, int G_, int c_, int M0, int G0) { const bool lo = c_ < G0; StaticOrder::init(lo ? M0 : M - M0, N, lo ? G0 : G_ - G0, lo ? c_ : c_ - G0); pm_off = lo ? 0 : M0 / BM;
        wgm = (G / NXCD) / nN; if (wgm < 1) wgm = 1; }
    __host__ __device__ bool next(int i, Unit& u) const {
        const long L = (long)i * G + c; if (L >= nwg) return false;
        int wgid = (int)L; { const int q = nwg / NXCD, r = nwg % NXCD, xcd = wgid % NXCD, off = wgid / NXCD; wgid = (xcd < r ? xcd * (q + 1) : r * (q + 1) + (xcd - r) * q) + off; }
        const int nig = wgm * nN, gid = wgid / nig, fm = gid * wgm, gsz = (nM - fm) < wgm ? (nM - fm) : wgm;
        u.pm = pm_off + fm + ((wgid % nig) % gsz); u.pn = (wgid % nig) / gsz; return true;
    }
};
struct TwoStageOrder : StaticOrder {
    int nM0, n0; const unsigned* ctr; unsigned need; mutable int seen;
    __host__ __device__ void init(int M, int N, int G_, int c_, int M0, const unsigned* ctr_, unsigned need_) { StaticOrder::init(M, N, G_, c_); nM0 = M0 / BM; n0 = nM0 * nN; ctr = ctr_; need = need_; seen = 0; }
    __host__ __device__ bool next(int i, Unit& u) const {
        const long L = (long)i * G + c; if (L >= nwg) return false;
        const bool late = L >= n0; int wgid = late ? (int)L - n0 : (int)L; const int nw = late ? nwg - n0 : n0, nMs = late ? nM - nM0 : nM0;
        { const int q = nw / NXCD, r = nw % NXCD, xcd = wgid % NXCD, off = wgid / NXCD; wgid = (xcd < r ? xcd * (q + 1) : r * (q + 1) + (xcd - r) * q) + off; }
        const int nig = WGM * nN, gid = wgid / nig, fm = gid * WGM, gsz = (nMs - fm) < WGM ? (nMs - fm) : WGM;
        u.pm = (late ? nM0 : 0) + fm + ((wgid % nig) % gsz); u.pn = (wgid % nig) / gsz; return true;
    }
    __device__ __forceinline__ void a_ready(const Unit& u) const {
        if (u.pm >= nM0 && !seen) { seen = 1;
            if (threadIdx.x < 64) { unsigned spins = 0;
                while ((unsigned)__builtin_amdgcn_readfirstlane(__hip_atomic_load(ctr, __ATOMIC_RELAXED, __HIP_MEMORY_SCOPE_AGENT)) < need) { __builtin_amdgcn_s_sleep(8); if (++spins > (1u << 22)) break; }
                __builtin_amdgcn_fence(__ATOMIC_ACQUIRE, "agent");
                asm volatile("s_waitcnt vmcnt(0)" ::: "memory"); }
            __builtin_amdgcn_s_barrier(); }
    }
};

__device__ __forceinline__ unsigned cvt_pk_bf16(float lo, float hi) { unsigned r; asm volatile("v_cvt_pk_bf16_f32 %0, %1, %2" : "=v"(r) : "v"(lo), "v"(hi)); return r; }
__device__ __forceinline__ float silu_f(float a) { return a * __builtin_amdgcn_rcpf(1.0f + __expf(-a)); }

__device__ __forceinline__ float swiglu2(float a, float b) { return (a * b) * __builtin_amdgcn_rcpf(1.0f + __builtin_amdgcn_exp2f(-a)); }
#ifndef KLOOP_REPS
#define KLOOP_REPS_ 1
#else
#define KLOOP_REPS_ KLOOP_REPS
#endif
struct EpiSwiglu {
    static constexpr int KREP = KLOOP_REPS_;
    static constexpr bool PERM = true, AFTER_DRAIN = false;
    bf16_t* O; int ldc;
    __device__ __forceinline__ void operator()(const f32x4 (&acc)[2][2][4][2], const Unit& u, int wr, int wc, int fr, int fq) const {
        const int row0 = u.pm * BM + wr * 64 + fr, col0 = u.pn * HALF + wc * 32 + 8 * fq;
#pragma unroll
        for (int ai = 0; ai < 2; ++ai)
#pragma unroll
            for (int m = 0; m < 4; ++m) { bf16_t* rowp = O + (size_t)(row0 + ai * HALF + m * 16) * ldc + col0;
                const f32x4 a0 = acc[ai][0][m][0], a1 = acc[ai][0][m][1], b0 = acc[ai][1][m][0], b1 = acc[ai][1][m][1];
                u32x4 w;
                w.x = cvt_pk_bf16(swiglu2(a0[0], b0[0]), swiglu2(a0[1], b0[1])); w.y = cvt_pk_bf16(swiglu2(a0[2], b0[2]), swiglu2(a0[3], b0[3]));
                w.z = cvt_pk_bf16(swiglu2(a1[0], b1[0]), swiglu2(a1[1], b1[1])); w.w = cvt_pk_bf16(swiglu2(a1[2], b1[2]), swiglu2(a1[3], b1[3]));
                *(u32x4*)rowp = w; }
    }
};

template <bool BB, bool OB>
struct EpiResid {
    static constexpr int KREP = 1;
    static constexpr bool PERM = true, AFTER_DRAIN = false;
    const void* base0; const void* base1; int split_row; void* out; int ldc; const float* gate; int mod_ld; float coef;
    __device__ __forceinline__ void operator()(const f32x4 (&acc)[2][2][4][2], const Unit& u, int wr, int wc, int fr, int fq) const {
        const int row0 = u.pm * BM + wr * 64 + fr, col0 = u.pn * BM + wc * 32 + 8 * fq;
        const int midx = u.pm < 16 ? 0 : 1 + ((u.pm - 16) >> 4);
        const float* gp = gate + (size_t)midx * mod_ld + col0;
        f32x4 gv[2][2];
#pragma unroll
        for (int bj = 0; bj < 2; ++bj)
#pragma unroll
            for (int n = 0; n < 2; ++n) gv[bj][n] = *(const f32x4*)(gp + bj * HALF + n * 4) * coef;
#pragma unroll
        for (int ai = 0; ai < 2; ++ai)
#pragma unroll
            for (int m = 0; m < 4; ++m) { const int r = row0 + ai * HALF + m * 16;
                const size_t boff = (r < split_row ? (size_t)r : (size_t)(r - split_row)) * ldc + col0, ooff = (size_t)r * ldc + col0;
                const void* bsel = r < split_row ? base0 : base1;
#pragma unroll
                for (int bj = 0; bj < 2; ++bj) { f32x4 b0, b1;
                    if (BB) { const u32x4 w = *(const u32x4*)((const bf16_t*)bsel + boff + bj * HALF);
                        b0 = (f32x4){__builtin_bit_cast(float, w.x << 16), __builtin_bit_cast(float, w.x & 0xffff0000u), __builtin_bit_cast(float, w.y << 16), __builtin_bit_cast(float, w.y & 0xffff0000u)};
                        b1 = (f32x4){__builtin_bit_cast(float, w.z << 16), __builtin_bit_cast(float, w.z & 0xffff0000u), __builtin_bit_cast(float, w.w << 16), __builtin_bit_cast(float, w.w & 0xffff0000u)}; }
                    else { const float* bp = (const float*)bsel + boff + bj * HALF; b0 = *(const f32x4*)bp; b1 = *(const f32x4*)(bp + 4); }
                    const f32x4 o0 = b0 + gv[bj][0] * acc[ai][bj][m][0], o1 = b1 + gv[bj][1] * acc[ai][bj][m][1];
                    if (OB) { u32x4 w; w.x = cvt_pk_bf16(o0[0], o0[1]); w.y = cvt_pk_bf16(o0[2], o0[3]); w.z = cvt_pk_bf16(o1[0], o1[1]); w.w = cvt_pk_bf16(o1[2], o1[3]);
                        *(u32x4*)((bf16_t*)out + ooff + bj * HALF) = w; }
                    else { float* op = (float*)out + ooff + bj * HALF; *(f32x4*)op = o0; *(f32x4*)(op + 4) = o1; } }
            }
    }
};

struct EpiMixIn {
    static constexpr int KREP = 1;
    static constexpr bool PERM = true, AFTER_DRAIN = false;
    bf16_t* CB; bf16_t* UC; bf16_t* QKV; bf16_t* SZ;
    __device__ __forceinline__ void operator()(const f32x4 (&acc)[2][2][4][2], const Unit& u, int wr, int wc, int fr, int fq) const {
        const int row0 = u.pm * BM + wr * 64 + fr, lc = wc * 32 + 8 * fq;
        if (u.pn >= 2 && u.pn < 6) {
            const int col0 = (u.pn - 2) * HALF + lc;
#pragma unroll
            for (int ai = 0; ai < 2; ++ai)
#pragma unroll
                for (int m = 0; m < 4; ++m) { bf16_t* rowp = UC + (size_t)(row0 + ai * HALF + m * 16) * 512 + col0;
                    const f32x4 a0 = acc[ai][0][m][0], a1 = acc[ai][0][m][1], b0 = acc[ai][1][m][0], b1 = acc[ai][1][m][1];
                    u32x4 w; w.x = cvt_pk_bf16(a0[0] * b0[0], a0[1] * b0[1]); w.y = cvt_pk_bf16(a0[2] * b0[2], a0[3] * b0[3]);
                    w.z = cvt_pk_bf16(a1[0] * b1[0], a1[1] * b1[1]); w.w = cvt_pk_bf16(a1[2] * b1[2], a1[3] * b1[3]);
                    *(u32x4*)rowp = w; }
        } else {
            bf16_t* base; int ld, col0; bool act = false;
            if (u.pn < 2) { base = CB; ld = 512; col0 = u.pn * BM + lc; }
            else if (u.pn < 12) { base = QKV; ld = 1536; col0 = (u.pn - 6) * BM + lc; }
            else { base = SZ; ld = 512; col0 = (u.pn - 12) * BM + lc; act = true; }
#pragma unroll
            for (int ai = 0; ai < 2; ++ai)
#pragma unroll
                for (int m = 0; m < 4; ++m) { bf16_t* rowp = base + (size_t)(row0 + ai * HALF + m * 16) * ld + col0;
#pragma unroll
                    for (int bj = 0; bj < 2; ++bj) { f32x4 v0 = acc[ai][bj][m][0], v1 = acc[ai][bj][m][1];
                        if (act) { v0 = (f32x4){silu_f(v0[0]), silu_f(v0[1]), silu_f(v0[2]), silu_f(v0[3])}; v1 = (f32x4){silu_f(v1[0]), silu_f(v1[1]), silu_f(v1[2]), silu_f(v1[3])}; }
                        u32x4 w; w.x = cvt_pk_bf16(v0[0], v0[1]); w.y = cvt_pk_bf16(v0[2], v0[3]); w.z = cvt_pk_bf16(v1[0], v1[1]); w.w = cvt_pk_bf16(v1[2], v1[3]);
                        *(u32x4*)(rowp + bj * HALF) = w; } }
        }
    }
};

typedef float f32x2 __attribute__((ext_vector_type(2)));
template <class Epi, class Sched, bool ALIGN_EPI = false, bool SP2 = false, bool SPLITA = false>
__device__ __forceinline__ void gemm_phase(PG8_LAS unsigned char* lds, const Gemm g, const Sched& S, const Epi& E) {
    const int tid = threadIdx.x, wid = __builtin_amdgcn_readfirstlane(tid >> 6), lane = tid & 63, wr = wid >> 2, wc = wid & 3, fr = lane & 15, fq = lane >> 4;
    const int K = g.K, nt = K / BK;
    unsigned voffA[2], voffB[2];
#pragma unroll
    for (int i = 0; i < 2; ++i) { int R, C; stage_rc(tid * 16 + i * 8192, R, C); const int Rb = Epi::PERM ? ((R & ~31) + perm32(R & 31)) : R;
        voffA[i] = (unsigned)(R * g.lda + C) * 2u; voffB[i] = (unsigned)(Rb * K + C) * 2u; }
    const size_t kstep = (size_t)(BK * 2);
    const size_t hstep = (size_t)HALF * K * 2;
    const size_t tstep = 2 * hstep;
    const size_t hstepA = (size_t)HALF * g.lda * 2, tstepA = 2 * hstepA;
    const int ksplit = g.ksplit;
    const unsigned ldsw = (unsigned)wid * 1024u;
    const int aoff = lds_byte(wr * 64 + fr, fq * 8), boff = lds_byte(wc * 32 + fr, fq * 8);
#define PG8_SA(b, h) (((b) * 2 + (h)) * HTB)
#define PG8_SB(b, h) ((4 + (b) * 2 + (h)) * HTB)
#define PG8_STAGE(bufoff, gbase, voff) do { _Pragma("unroll") for (int _i = 0; _i < 2; ++_i) \
        __builtin_amdgcn_global_load_lds((const unsigned*)((const char*)(gbase) + (voff)[_i]), (PG8_LAS unsigned*)(lds + (bufoff) + ldsw + _i * 8192), 16, 0, 0); } while (0)
#define PG8_LDA(dst, b, h) do { _Pragma("unroll") for (int m = 0; m < 4; ++m) _Pragma("unroll") for (int k = 0; k < 2; ++k) dst[m][k] = *(const PG8_LAS bf16x8*)(lds + PG8_SA(b, h) + aoff + m * 2048 + k * 1024); } while (0)
#define PG8_LDB(dst, b, h) do { _Pragma("unroll") for (int n = 0; n < 2; ++n) _Pragma("unroll") for (int k = 0; k < 2; ++k) dst[n][k] = *(const PG8_LAS bf16x8*)(lds + PG8_SB(b, h) + boff + n * 2048 + k * 1024); } while (0)
#define PG8_MMA(ai, bj, At, Bt) do { __builtin_amdgcn_s_setprio(1); _Pragma("unroll") for (int m = 0; m < 4; ++m) _Pragma("unroll") for (int n = 0; n < 2; ++n) _Pragma("unroll") for (int k = 0; k < 2; ++k) \
        acc[ai][bj][m][n] = __builtin_amdgcn_mfma_f32_16x16x32_bf16(Bt[n][k], At[m][k], acc[ai][bj][m][n], 0, 0, 0); __builtin_amdgcn_s_setprio(0); } while (0)
#define PG8_WAIT_V(n) asm volatile("s_waitcnt vmcnt(" #n ")" ::: "memory")
#define PG8_WAIT_L(n) asm volatile("s_waitcnt lgkmcnt(" #n ")" ::: "memory")
#define PG8_BAR __builtin_amdgcn_s_barrier()
#define PG8_SCHED __builtin_amdgcn_sched_barrier(0)
    Unit cur, nxt; int ui = 0;
    if (!S.next(0, cur)) return;
    f32x4 acc[2][2][4][2];
#pragma unroll
    for (int a = 0; a < 2; ++a)
#pragma unroll
        for (int b = 0; b < 2; ++b)
#pragma unroll
            for (int m = 0; m < 4; ++m)
#pragma unroll
                for (int n = 0; n < 2; ++n) acc[a][b][m][n] = (f32x4){0.f, 0.f, 0.f, 0.f};
    bf16x8 At[4][2], B0[2][2], B1[2][2];
    const char* cA = (const char*)g.A + (size_t)cur.pm * tstepA; const char* cA2 = (const char*)g.A2 + (size_t)cur.pm * tstepA; const char* cB = (const char*)g.Bt + (size_t)cur.pn * tstep;
    S.a_ready(cur);
    if constexpr (SP2) {
        PG8_STAGE(PG8_SB(0, 0), cB, voffB); PG8_STAGE(PG8_SB(0, 1), cB + hstep, voffB); PG8_STAGE(PG8_SA(0, 0), cA, voffA); PG8_STAGE(PG8_SA(0, 1), cA + hstepA, voffA);
        if (wr == 1) PG8_BAR;
        PG8_WAIT_V(2); PG8_BAR;
        PG8_STAGE(PG8_SB(1, 0), cB + kstep, voffB); PG8_STAGE(PG8_SA(1, 0), cA + kstep, voffA); PG8_STAGE(PG8_SB(1, 1), cB + hstep + kstep, voffB);
        PG8_WAIT_V(6); PG8_BAR;
    } else {
        PG8_STAGE(PG8_SB(0, 0), cB, voffB); PG8_STAGE(PG8_SA(0, 0), cA, voffA); PG8_STAGE(PG8_SB(0, 1), cB + hstep, voffB); PG8_STAGE(PG8_SA(0, 1), cA + hstepA, voffA);
        if (wr == 1) PG8_BAR;
        PG8_WAIT_V(4); PG8_BAR;
        PG8_STAGE(PG8_SB(1, 0), cB + kstep, voffB); PG8_STAGE(PG8_SA(1, 0), cA + kstep, voffA); PG8_STAGE(PG8_SB(1, 1), cB + hstep + kstep, voffB);
        PG8_WAIT_V(6); PG8_BAR;
    }
    for (;;) {
        const bool has_next = S.next(ui + 1, nxt);
        const char* nA = has_next ? (const char*)g.A + (size_t)nxt.pm * tstepA : cA; const char* nB = has_next ? (const char*)g.Bt + (size_t)nxt.pn * tstep : cB;
#ifdef KLOOP_REPS
        constexpr int KR = Epi::KREP;
#else
        constexpr int KR = 1;
#endif
        for (int tt = 0; tt < nt * KR; tt += 2) {
            const int t = KR > 1 ? tt % nt : tt;
            const bool last = (tt == nt * KR - 2);
            const int t2 = (KR > 1 && t + 2 >= nt) ? 0 : t + 2;
            const char* a1 = (SPLITA && t + 1 >= ksplit ? cA2 : cA) + (size_t)(t + 1) * kstep;
            const char* a2 = last ? nA : (SPLITA && t2 >= ksplit ? cA2 : cA) + (size_t)t2 * kstep; const char* b2 = last ? nB : cB + (size_t)t2 * kstep;
            const char* a3 = a2 + kstep; const char* b3 = b2 + kstep;
            if (last && has_next) S.a_ready(nxt);
            if constexpr (SP2) {
            PG8_LDB(B0, 0, 0); PG8_LDB(B1, 0, 1); PG8_SCHED; PG8_LDA(At, 0, 0); PG8_STAGE(PG8_SA(1, 1), a1 + hstepA, voffA);
            PG8_WAIT_V(8); PG8_WAIT_L(0); PG8_BAR; PG8_MMA(0, 0, At, B0); PG8_MMA(0, 1, At, B1); PG8_BAR; PG8_SCHED;
            PG8_LDA(At, 0, 1); PG8_STAGE(PG8_SB(0, 0), b2, voffB); PG8_STAGE(PG8_SB(0, 1), b2 + hstep, voffB); PG8_STAGE(PG8_SA(0, 0), a2, voffA);
            PG8_WAIT_V(8); PG8_WAIT_L(0); PG8_BAR; PG8_MMA(1, 0, At, B0); PG8_MMA(1, 1, At, B1); PG8_BAR; PG8_SCHED;
            PG8_LDB(B0, 1, 0); PG8_LDB(B1, 1, 1); PG8_SCHED; PG8_LDA(At, 1, 0); PG8_STAGE(PG8_SA(0, 1), a2 + hstepA, voffA);
            PG8_WAIT_V(8); PG8_WAIT_L(0); PG8_BAR; PG8_MMA(0, 0, At, B0); PG8_MMA(0, 1, At, B1); PG8_BAR; PG8_SCHED;
            PG8_LDA(At, 1, 1); PG8_STAGE(PG8_SB(1, 0), b3, voffB); PG8_STAGE(PG8_SB(1, 1), b3 + hstep, voffB); PG8_STAGE(PG8_SA(1, 0), a3, voffA);
            PG8_WAIT_V(8); PG8_WAIT_L(0); PG8_BAR; PG8_MMA(1, 0, At, B0); PG8_MMA(1, 1, At, B1); PG8_BAR; PG8_SCHED;
            } else {
            PG8_LDB(B0, 0, 0); PG8_SCHED; PG8_LDA(At, 0, 0); PG8_STAGE(PG8_SA(1, 1), a1 + hstepA, voffA);
            PG8_WAIT_L(8); PG8_BAR; PG8_WAIT_L(0); PG8_MMA(0, 0, At, B0); PG8_BAR; PG8_SCHED;
            PG8_LDB(B1, 0, 1); PG8_STAGE(PG8_SB(0, 0), b2, voffB);
            PG8_BAR; PG8_WAIT_L(0); PG8_MMA(0, 1, At, B1); PG8_BAR;
            PG8_LDA(At, 0, 1); PG8_STAGE(PG8_SA(0, 0), a2, voffA);
            PG8_BAR; PG8_WAIT_L(0); PG8_MMA(1, 0, At, B0); PG8_BAR; PG8_SCHED;
            PG8_STAGE(PG8_SB(0, 1), b2 + hstep, voffB);
            PG8_WAIT_V(6); PG8_BAR; PG8_MMA(1, 1, At, B1); PG8_BAR;
            PG8_LDB(B0, 1, 0); PG8_SCHED; PG8_LDA(At, 1, 0); PG8_STAGE(PG8_SA(0, 1), a2 + hstepA, voffA);
            PG8_WAIT_L(8); PG8_BAR; PG8_WAIT_L(0); PG8_MMA(0, 0, At, B0); PG8_BAR; PG8_SCHED;
            PG8_LDB(B1, 1, 1); PG8_STAGE(PG8_SB(1, 0), b3, voffB);
            PG8_BAR; PG8_WAIT_L(0); PG8_MMA(0, 1, At, B1); PG8_BAR;
            PG8_LDA(At, 1, 1); PG8_STAGE(PG8_SA(1, 0), a3, voffA);
            PG8_BAR; PG8_WAIT_L(0); PG8_MMA(1, 0, At, B0); PG8_BAR; PG8_SCHED;
            PG8_STAGE(PG8_SB(1, 1), b3 + hstep, voffB);
            PG8_WAIT_V(6); PG8_BAR; PG8_MMA(1, 1, At, B1); PG8_BAR;
            }
        }
        if constexpr (ALIGN_EPI) { if (wr == 0) PG8_BAR; }
        if constexpr (KR > 1) {
#pragma unroll
            for (int a = 0; a < 2; ++a)
#pragma unroll
                for (int b = 0; b < 2; ++b)
#pragma unroll
                    for (int m = 0; m < 4; ++m)
#pragma unroll
                        for (int n = 0; n < 2; ++n) acc[a][b][m][n] *= (1.0f / KR); }
        if constexpr (!Epi::AFTER_DRAIN) { E(acc, cur, wr, wc, fr, fq); S.done(cur); }
        if (!has_next) break;
#pragma unroll
        for (int a = 0; a < 2; ++a)
#pragma unroll
            for (int b = 0; b < 2; ++b)
#pragma unroll
                for (int m = 0; m < 4; ++m)
#pragma unroll
                    for (int n = 0; n < 2; ++n) { f32x2 lo, hi; asm volatile("v_mov_b64 %0, 0" : "=v"(lo)); asm volatile("v_mov_b64 %0, 0" : "=v"(hi)); acc[a][b][m][n] = (f32x4){lo.x, lo.y, hi.x, hi.y}; }
        cur = nxt; cA = nA; cA2 = (const char*)g.A2 + (size_t)cur.pm * tstepA; cB = nB; ++ui;
        if constexpr (ALIGN_EPI) { if (wr == 1) PG8_BAR; }
    }
    PG8_WAIT_V(0);
    if constexpr (!ALIGN_EPI) { if (wr == 0) PG8_BAR; }
    PG8_BAR;
    if constexpr (Epi::AFTER_DRAIN) { E.fused(acc, cur, wr, wc, fr, fq, lds, wid, lane); S.done(cur); }
#undef PG8_SA
#undef PG8_SB
#undef PG8_STAGE
#undef PG8_LDA
#undef PG8_LDB
#undef PG8_MMA
#undef PG8_WAIT_V
#undef PG8_WAIT_L
#undef PG8_BAR
#undef PG8_SCHED
}
}

constexpr int NWAVES = 8;
constexpr int D = 1024, TP = 4096, TS = 32768, T = TP + TS, FF = 2816, NFFI = 2 * FF, NMIX = 3584, PROJ = 3600;
constexpr int NB_P = 16, L_P = 256, NB_S = 8, L_S = 4096, NH = 4, DKV = 128, NMOD = 9 * D;
constexpr float EPS = 1e-6f;
#ifndef MK_N_LAUNCHES
#define MK_N_LAUNCHES 1
#endif
constexpr int N_PHASES = 14;
#ifndef PREP_PROBE_DM
#define PREP_PROBE_DM 3
#endif
#ifndef GEMM_SP2
#define GEMM_SP2 true
#endif
#ifndef RESID_ALIGN
#define RESID_ALIGN true
#endif
#ifndef NOSHADOW
#define NOSHADOW 0
#endif
#ifndef SWIGLU_ALIGN
#define SWIGLU_ALIGN true
#endif
#ifndef W2_IN_P0
#define W2_IN_P0 2
#endif
#ifndef CONV_IN_SCAN
#define CONV_IN_SCAN 1
#endif

constexpr size_t MiB = 1u << 20;
constexpr size_t WS_CTL = 0, CTL_ZERO_BYTES = 256 * 1024;
constexpr size_t WS_MOD = 1 * MiB;
constexpr size_t WS_GSC = 2 * MiB, GSC_STRIDE = (size_t)T * 4 * 4;
constexpr size_t WS_WF1I = 6 * MiB, WS_WF1O = 17 * MiB, WS_WMI = 23 * MiB, WS_WMO = 30 * MiB, WS_WF2I = 32 * MiB, WS_WF2O = 43 * MiB;
constexpr size_t WS_H = 50 * MiB;
constexpr size_t WS_ACT = 122 * MiB;
constexpr size_t WS_CB = 122 * MiB, WS_UC = 158 * MiB, WS_SZ = 194 * MiB, WS_QKV = 230 * MiB;
constexpr size_t WS_END = 512 * MiB;
constexpr int CW_BAR = 4096;
constexpr int CW_ADA_DONE = 384;
constexpr int CW_Q_CONV = 64, CW_Q_WT = 128, CW_Q_N2 = 192, CW_Q_N3 = 256, CW_Q_NF = 320;
constexpr int CW_TAIL2 = 448, CW_TAIL3 = 512;
constexpr int CW_EDONE = 640;
constexpr int CW_XPUB = 8192, CW_ECNT = 14336;
constexpr int CW_RDY = 32768, RDY_BANK = 160 * 64;
constexpr size_t WS_YC = 306 * MiB;
constexpr size_t WS_YD = 50 * MiB;
constexpr size_t WS_X2B = 420 * MiB;
constexpr size_t WS_H3 = 342 * MiB;
static_assert((CW_RDY + 3 * RDY_BANK) * 4 <= (int)CTL_ZERO_BYTES && (CW_BAR + 3456) * 4 <= (int)CTL_ZERO_BYTES, "control words inside the per-call memset");

constexpr int RING_OFF = 0, RING_BYTES = 131072;
constexpr int LDS_BYTES = 163840;
constexpr int LDSCTL_OFF = LDS_BYTES - 512, MISC_OFF = LDSCTL_OFF + 320;

#define GAS __attribute__((address_space(1)))
#define LAS __attribute__((address_space(3)))
typedef unsigned short bf16;
typedef unsigned v4u __attribute__((ext_vector_type(4)));
typedef unsigned v2u __attribute__((ext_vector_type(2)));
typedef float f32x4 __attribute__((ext_vector_type(4)));
typedef short bf16x8 __attribute__((ext_vector_type(8)));
typedef GAS unsigned gu32;
#define RLX_AGENT __ATOMIC_RELAXED, __HIP_MEMORY_SCOPE_AGENT
#define LDS_WAIT() asm volatile("s_waitcnt lgkmcnt(0)" ::: "memory")
#define VM_WAIT() asm volatile("s_waitcnt vmcnt(0)" ::: "memory")
__device__ __forceinline__ unsigned f2bf(float f) { unsigned u = __builtin_bit_cast(unsigned, f); return (u + 0x7fffu + ((u >> 16) & 1u)) >> 16; }
__device__ __forceinline__ unsigned pk2(float lo, float hi) { return f2bf(lo) | (f2bf(hi) << 16); }
__device__ __forceinline__ float bf2f(unsigned short u) { return __builtin_bit_cast(float, (unsigned)u << 16); }
__device__ __forceinline__ float bflo(unsigned w) { return __builtin_bit_cast(float, w << 16); }
__device__ __forceinline__ float bfhi(unsigned w) { return __builtin_bit_cast(float, w & 0xffff0000u); }
__device__ __forceinline__ float siluf(float a) { return a / (1.0f + __expf(-a)); }
#define XB_TMO      128
#define XB_XCNT(j)  (256  + 64 * (j))
#define XB_XSUB(j)  (1280 + 64 * (j))
#define XB_XGEN(j)  (2304 + 64 * (j))
#define XB_TOP      3328
#define XB_TOPGEN   3392
#define XCD_BAR_WORDS 3456
#define XB_SPIN_CAP (1u << 18)

__device__ __forceinline__ unsigned xb_ld(unsigned* p)              { return __hip_atomic_load(p, __ATOMIC_RELAXED, __HIP_MEMORY_SCOPE_AGENT); }
__device__ __forceinline__ unsigned xb_add(unsigned* p, unsigned v) { return __hip_atomic_fetch_add(p, v, __ATOMIC_RELAXED, __HIP_MEMORY_SCOPE_AGENT); }
__device__ __forceinline__ unsigned xb_xcc_id() { return (unsigned)__builtin_amdgcn_s_getreg((3 << 11) | 20) & 0xFu; }
#define XB_SPIN(cond, bar) do { unsigned _sp = 0; while (cond) { if (_sp < 8u) __builtin_amdgcn_s_sleep(1); else __builtin_amdgcn_s_sleep(32); \
    if ((++_sp & 255u) == 0u) { if (xb_ld(&(bar)[XB_TMO])) break; if (_sp > XB_SPIN_CAP) { atomicAdd(&(bar)[XB_TMO], 1u); break; } } } } while (0)

struct XcdBarrier {
    unsigned* bar; unsigned x;
    volatile LAS unsigned* st;
};

__device__ __forceinline__ XcdBarrier xcd_barrier_post(unsigned* bar, volatile LAS unsigned* st) {
    XcdBarrier b; b.bar = bar; b.x = xb_xcc_id(); b.st = st;
    if (threadIdx.x == 0) (void)xb_add(&bar[XB_XCNT(b.x)], 1u);
    return b;
}
__device__ __forceinline__ void xcd_barrier_complete(unsigned* bar, unsigned x, unsigned& nloc, unsigned& nx) {
    const unsigned G = gridDim.x * gridDim.y * gridDim.z;
    unsigned sum, cnt, mine, sp = 0u;
    for (;;) {
        sum = 0u; cnt = 0u; mine = 0u;
#pragma unroll
        for (unsigned j = 0; j < 16; ++j) { const unsigned c = xb_ld(&bar[XB_XCNT(j)]); sum += c; cnt += (c > 0u) ? 1u : 0u; mine = (j == x) ? c : mine; }
        if (sum == G) break;
        __builtin_amdgcn_s_sleep(1);
        if ((++sp & 255u) == 0u) { if (xb_ld(&bar[XB_TMO])) break; if (sp > XB_SPIN_CAP) { atomicAdd(&bar[XB_TMO], 1u); break; } }
    }
    nloc = mine > 0u ? mine : 1u; nx = cnt > 0u ? cnt : 1u;
}

__device__ __forceinline__ void xcd_barrier(const XcdBarrier& b) {
    asm volatile("s_waitcnt vmcnt(0)" ::: "memory");
    __syncthreads();
    if (threadIdx.x == 0) {
        unsigned* bar = b.bar;
        __builtin_amdgcn_s_waitcnt(0);
        unsigned nloc = b.st[0], nx = b.st[1];
        if (nloc == 0u) { xcd_barrier_complete(bar, b.x, nloc, nx); b.st[0] = nloc; b.st[1] = nx; }
        const unsigned old = xb_add(&bar[XB_XSUB(b.x)], 1u);
        const unsigned gen = old / nloc;
        if (old + 1u == (gen + 1u) * nloc) {
            __builtin_amdgcn_fence(__ATOMIC_RELEASE, "agent");
            asm volatile("s_waitcnt vmcnt(0)" ::: "memory");
            const unsigned og = xb_add(&bar[XB_TOP], 1u);
            const unsigned tg = og / nx;
            if (og + 1u == (tg + 1u) * nx) xb_add(&bar[XB_TOPGEN], 1u);
            else XB_SPIN(xb_ld(&bar[XB_TOPGEN]) == tg, bar);
            __builtin_amdgcn_fence(__ATOMIC_ACQUIRE, "agent");
            xb_add(&bar[XB_XGEN(b.x)], 1u);
            asm volatile("s_waitcnt vmcnt(0)" ::: "memory");
        } else {
            XB_SPIN(xb_ld(&bar[XB_XGEN(b.x)]) == gen, bar);
            __builtin_amdgcn_fence(__ATOMIC_ACQUIRE, "agent");
            asm volatile("s_waitcnt vmcnt(0)" ::: "memory");
        }
    }
    __syncthreads();
}

struct Frame {
    LAS unsigned char* lds;
    volatile LAS unsigned* MISC;
    gu32* ctl;
    int tid, lane, wave;
    int vcu, G;
    unsigned xcc;
    const float* const* in; float* out; unsigned char* ws;
};
enum { I_XP = 0, I_XS, I_SF, I_SB, I_C, I_CCTX, I_WADA, I_BADA, I_NF1, I_WF1I, I_WF1O, I_NMIX, I_WMI, I_CONVW, I_DNCONVW, I_ALOG, I_DTB, I_DNNORM, I_WMO, I_NF2, I_WF2I, I_WF2O, I_NFIN };

__device__ __forceinline__ float wave_sum(float v) {
#pragma unroll
    for (int o = 1; o < 64; o <<= 1) v += __shfl_xor(v, o);
    return v;
}

__device__ __forceinline__ void p0_transpose_item(const float* W, int K, int ldw, bf16* WT, int kb, int n0, int drow, LAS float* scr, int lane, float scale = 1.0f) {
    const int k0 = 64 * kb;
    f32x4 tv[8];
#pragma unroll
    for (int i = 0; i < 8; ++i) { const int kk = 8 * i + (lane >> 3); tv[i] = *(const f32x4*)(W + (size_t)(k0 + kk) * ldw + n0 + 4 * (lane & 7)) * scale; }
#pragma unroll
    for (int i = 0; i < 8; ++i) { const int kk = 8 * i + (lane >> 3); LAS float* d = scr + kk * 33 + 4 * (lane & 7); d[0] = tv[i].x; d[1] = tv[i].y; d[2] = tv[i].z; d[3] = tv[i].w; }
    LDS_WAIT(); asm volatile("" ::: "memory");
    const int c = lane & 7;
#pragma unroll
    for (int j = 0; j < 4; ++j) { const int n = (lane >> 3) + 8 * j; const LAS float* s = scr + (8 * c) * 33 + n;
        v4u o; o.x = pk2(s[0 * 33], s[1 * 33]); o.y = pk2(s[2 * 33], s[3 * 33]); o.z = pk2(s[4 * 33], s[5 * 33]); o.w = pk2(s[6 * 33], s[7 * 33]);
        *(GAS v4u*)(WT + (size_t)(drow + n) * K + k0 + 8 * c) = o; }
    LDS_WAIT(); asm volatile("" ::: "memory");
}
__device__ __forceinline__ int ffi_drow(int n0) { return n0 < FF ? 256 * (n0 >> 7) + (n0 & 127) : 256 * ((n0 - FF) >> 7) + 128 + ((n0 - FF) & 127); }
__device__ __forceinline__ float ffi_scale(int n0) { return n0 < FF ? 1.44269504088896341f : 0.693147180559945309f; }
__device__ __forceinline__ int mi_drow(int n0) {
    if (n0 < 512 || n0 >= 1536) return n0;
    if (n0 < 1024) { const int j = n0 - 512; return 512 + 256 * (j >> 7) + (j & 127); }
    const int j = n0 - 1024; return 512 + 256 * (j >> 7) + 128 + (j & 127);
}

__device__ __forceinline__ void p0_prologue(Frame& F) {
    if ((int)blockIdx.x < NMOD / 64) {
        LAS float* sc = (LAS float*)(F.lds);
        LAS float* red = (LAS float*)(F.lds + 49152);
        { float cv[18];
#pragma unroll
          for (int i = 0; i < 18; ++i) { const int idx = F.tid + i * (NWAVES * 64), r = idx >> 10, k = idx & 1023; cv[i] = r == 0 ? F.in[I_CCTX][k] : F.in[I_C][(r - 1) * D + k]; }
#pragma unroll
          for (int i = 0; i < 18; ++i) { const int idx = F.tid + i * (NWAVES * 64), r = idx >> 10, k = idx & 1023; sc[k * 12 + r] = siluf(cv[i]); } }
        __syncthreads();
        const int n0 = blockIdx.x * 64; const float* W = F.in[I_WADA];
        const int c4 = F.lane & 15, rs = F.lane >> 4;
        f32x4 acc4[9];
#pragma unroll
        for (int r = 0; r < 9; ++r) acc4[r] = (f32x4){0.f, 0.f, 0.f, 0.f};
        const int kbeg = F.wave * 128;
#pragma unroll 1
        for (int kb = kbeg; kb < kbeg + 128; kb += 32) {
            f32x4 wv[8];
#pragma unroll
            for (int i = 0; i < 8; ++i) wv[i] = *(const f32x4*)(W + (size_t)(kb + 4 * i + rs) * NMOD + n0 + 4 * c4);
#pragma unroll
            for (int i = 0; i < 8; ++i) { const LAS float* s = sc + (kb + 4 * i + rs) * 12;
                const f32x4 s0 = *(const LAS f32x4*)s, s1 = *(const LAS f32x4*)(s + 4); const float s8 = s[8];
                acc4[0] += s0.x * wv[i]; acc4[1] += s0.y * wv[i]; acc4[2] += s0.z * wv[i]; acc4[3] += s0.w * wv[i];
                acc4[4] += s1.x * wv[i]; acc4[5] += s1.y * wv[i]; acc4[6] += s1.z * wv[i]; acc4[7] += s1.w * wv[i]; acc4[8] += s8 * wv[i]; } }
#pragma unroll
        for (int r = 0; r < 9; ++r) {
#pragma unroll
            for (int t = 0; t < 4; ++t) { float v = acc4[r][t]; v += __shfl_xor(v, 16); v += __shfl_xor(v, 32); acc4[r][t] = v; }
            if (rs == 0) *(LAS f32x4*)(red + (F.wave * 9 + r) * 64 + 4 * c4) = acc4[r]; }
        __syncthreads();
        for (int idx = F.tid; idx < 9 * 64; idx += NWAVES * 64) { const int r = idx >> 6, c = idx & 63; float s = F.in[I_BADA][n0 + c];
#pragma unroll
            for (int w = 0; w < 8; ++w) s += red[(w * 9 + r) * 64 + c];
            ((float*)(F.ws + WS_MOD))[r * NMOD + n0 + c] = s; }
        __syncthreads();
    }
    LAS float* scr = (LAS float*)(F.lds + RING_OFF + F.wave * 16384);
    const int gw = F.vcu * NWAVES + F.wave, NGW = F.G * NWAVES;
    constexpr int I_FI = (D / 64) * (NFFI / 32), I_FO = (FF / 64) * (D / 32), I_MI = (D / 64) * (NMIX / 32), I_MO = (D / 64) * (D / 32);
#if W2_IN_P0 == 1
    constexpr int NITEMS = 2 * I_FI + 2 * I_FO + I_MI + I_MO;
#else
    constexpr int NITEMS = I_FI + I_FO + I_MI + I_MO;
#endif
    constexpr int N_ADA_BLK = NMOD / 64, NW_A = N_ADA_BLK * NWAVES, NW_B = (256 - N_ADA_BLK) * NWAVES;
    constexpr int NITEMS_B = (int)((long)NITEMS * (NW_B * 28) / (NW_B * 28 + NW_A * 15));
    const bool ada_blk = (int)blockIdx.x < N_ADA_BLK && F.G == 256;
    const int it0 = F.G != 256 ? gw : (ada_blk ? NITEMS_B + (int)blockIdx.x * NWAVES + F.wave : ((int)blockIdx.x - N_ADA_BLK) * NWAVES + F.wave);
    const int it_end = F.G != 256 ? NITEMS : (ada_blk ? NITEMS : NITEMS_B), it_step = F.G != 256 ? NGW : (ada_blk ? NW_A : NW_B);
    for (int it = it0; it < it_end; it += it_step) {
        int r = it;
        if (r < I_FI) { const int nb = r % (NFFI / 32), kb = r / (NFFI / 32); p0_transpose_item(F.in[I_WF1I], D, NFFI, (bf16*)(F.ws + WS_WF1I), kb, 32 * nb, ffi_drow(32 * nb), scr, F.lane, ffi_scale(32 * nb)); continue; } r -= I_FI;
        if (r < I_FO) { const int nb = r % (D / 32), kb = r / (D / 32); p0_transpose_item(F.in[I_WF1O], FF, D, (bf16*)(F.ws + WS_WF1O), kb, 32 * nb, 32 * nb, scr, F.lane); continue; } r -= I_FO;
        if (r < I_MI) { const int nb = r % (NMIX / 32), kb = r / (NMIX / 32); p0_transpose_item(F.in[I_WMI], D, PROJ, (bf16*)(F.ws + WS_WMI), kb, 32 * nb, mi_drow(32 * nb), scr, F.lane); continue; } r -= I_MI;
        if (r < I_MO) { const int nb = r % (D / 32), kb = r / (D / 32); p0_transpose_item(F.in[I_WMO], D, D, (bf16*)(F.ws + WS_WMO), kb, 32 * nb, 32 * nb, scr, F.lane); continue; } r -= I_MO;
        if (r < I_FI) { const int nb = r % (NFFI / 32), kb = r / (NFFI / 32); p0_transpose_item(F.in[I_WF2I], D, NFFI, (bf16*)(F.ws + WS_WF2I), kb, 32 * nb, ffi_drow(32 * nb), scr, F.lane, ffi_scale(32 * nb)); continue; } r -= I_FI;
        { const int nb = r % (D / 32), kb = r / (D / 32); p0_transpose_item(F.in[I_WF2O], FF, D, (bf16*)(F.ws + WS_WF2O), kb, 32 * nb, 32 * nb, scr, F.lane); }
    }
}
__device__ __forceinline__ void wait_ada(Frame& F) {
    unsigned spins = 0;
    while ((unsigned)__builtin_amdgcn_readfirstlane(__hip_atomic_load(F.ctl + CW_ADA_DONE, RLX_AGENT)) < (unsigned)(NMOD / 64)) { __builtin_amdgcn_s_sleep(8); if (++spins > (1u << 22)) break; }
    __builtin_amdgcn_fence(__ATOMIC_ACQUIRE, "agent");
    asm volatile("s_waitcnt vmcnt(0)" ::: "memory");
}
__device__ __forceinline__ int q_take(gu32* head, unsigned n, int lane) {
    unsigned v = 0; if (lane == 0) v = __hip_atomic_fetch_add(head, n, RLX_AGENT);
    return (int)__builtin_amdgcn_readfirstlane(v);
}
__device__ __forceinline__ void ffn2_weights_queue(Frame& F, LAS float* scr) {
    constexpr int I_FI = (D / 64) * (NFFI / 32), I_FO = (FF / 64) * (D / 32);
    for (;;) { int r = q_take(F.ctl + CW_Q_WT, 1u, F.lane); if (r >= I_FI + I_FO) break;
        if (r < I_FI) { const int nb = r % (NFFI / 32), kb = r / (NFFI / 32); p0_transpose_item(F.in[I_WF2I], D, NFFI, (bf16*)(F.ws + WS_WF2I), kb, 32 * nb, ffi_drow(32 * nb), scr, F.lane, ffi_scale(32 * nb)); }
        else { r -= I_FI; const int nb = r % (D / 32), kb = r / (D / 32); p0_transpose_item(F.in[I_WF2O], FF, D, (bf16*)(F.ws + WS_WF2O), kb, 32 * nb, 32 * nb, scr, F.lane); } }
}

__device__ __forceinline__ void ffn2_weights_static(Frame& F, LAS float* scr, int wi, int nw) {
    constexpr int I_FI = (D / 64) * (NFFI / 32), I_FO = (FF / 64) * (D / 32);
    for (int r = wi; r < I_FI + I_FO; r += nw) {
        if (r < I_FI) { const int nb = r % (NFFI / 32), kb = r / (NFFI / 32); p0_transpose_item(F.in[I_WF2I], D, NFFI, (bf16*)(F.ws + WS_WF2I), kb, 32 * nb, ffi_drow(32 * nb), scr, F.lane, ffi_scale(32 * nb)); }
        else { const int q = r - I_FI; const int nb = q % (D / 32), kb = q / (D / 32); p0_transpose_item(F.in[I_WF2O], FF, D, (bf16*)(F.ws + WS_WF2O), kb, 32 * nb, 32 * nb, scr, F.lane); } }
}

#define NIDX(lane, j) (8 * (lane) + 512 * ((j) >> 1) + 4 * ((j) & 1))
template <bool SB> struct RowBuf;
template <> struct RowBuf<true> { v4u w[2]; };
template <> struct RowBuf<false> { f32x4 w[4]; };
template <bool SB>
__device__ __forceinline__ void norm_fetch(RowBuf<SB>& b, int m, const void* src0, const void* src1, int lane) {
    if constexpr (SB) { const bf16* xr = m < TP ? (const bf16*)src0 + (size_t)m * D : (const bf16*)src1 + (size_t)(m - TP) * D;
#pragma unroll
        for (int j = 0; j < 2; ++j) b.w[j] = *(const v4u*)(xr + 8 * lane + 512 * j); }
    else { const float* xr = m < TP ? (const float*)src0 + (size_t)m * D : (const float*)src1 + (size_t)(m - TP) * D;
#pragma unroll
        for (int j = 0; j < 4; ++j) b.w[j] = *(const f32x4*)(xr + NIDX(lane, j)); }
}
struct ModVec { f32x4 sh[4], sc[4]; int midx; };
__device__ __forceinline__ void mod_fetch(ModVec& mv, int m, const float* mod, int off_shift, int off_scale, int lane) {
    const int midx = m < TP ? 0 : 1 + ((m - TP) >> 12);
    if (midx != mv.midx) { mv.midx = midx; const float* mrow = mod + (size_t)midx * NMOD;
#pragma unroll
        for (int j = 0; j < 4; ++j) { mv.sh[j] = *(const f32x4*)(mrow + off_shift + NIDX(lane, j)); mv.sc[j] = *(const f32x4*)(mrow + off_scale + NIDX(lane, j)); } }
}
template <int MODE, bool SB>
__device__ __forceinline__ void norm_row(Frame& F, int m, const RowBuf<SB>& rb, const f32x4 (&gv)[4], const ModVec& mv, bf16* H, LAS float* wab) {
        f32x4 v[4]; float s = 0.f;
        if constexpr (SB) {
#pragma unroll
            for (int j = 0; j < 2; ++j) { const v4u w = rb.w[j]; v[2 * j] = (f32x4){bflo(w.x), bfhi(w.x), bflo(w.y), bfhi(w.y)}; v[2 * j + 1] = (f32x4){bflo(w.z), bfhi(w.z), bflo(w.w), bfhi(w.w)}; } }
        else {
#pragma unroll
            for (int j = 0; j < 4; ++j) v[j] = rb.w[j]; }
#pragma unroll
        for (int j = 0; j < 4; ++j) { s += (v[j].x * v[j].x + v[j].y * v[j].y) + (v[j].z * v[j].z + v[j].w * v[j].w); }
        const float rstd = 1.0f / sqrtf(wave_sum(s) * (1.f / D) + EPS);
        if (MODE == 2) {
            float* o = F.out + (size_t)m * D;
#pragma unroll
            for (int j = 0; j < 4; ++j) *(f32x4*)(o + NIDX(F.lane, j)) = v[j] * rstd * gv[j];
        } else {
#pragma unroll
            for (int j = 0; j < 4; ++j) v[j] = v[j] * rstd * gv[j] * (mv.sc[j] + 1.0f) + mv.sh[j];
#pragma unroll
            for (int jp = 0; jp < 2; ++jp) { v4u w; w.x = pk2(v[2 * jp].x, v[2 * jp].y); w.y = pk2(v[2 * jp].z, v[2 * jp].w); w.z = pk2(v[2 * jp + 1].x, v[2 * jp + 1].y); w.w = pk2(v[2 * jp + 1].z, v[2 * jp + 1].w);
                *(v4u*)(H + (size_t)m * D + 8 * F.lane + 512 * jp) = w; }
            if (MODE == 1) {
                float acc[16];
#pragma unroll
                for (int o = 0; o < 16; ++o) acc[o] = 0.f;
                int fence = 0;
#pragma unroll
                for (int j = 0; j < 4; ++j) {
                    asm volatile("" : "+v"(fence), "+v"(acc[0]));
#pragma unroll
                    for (int o = 0; o < 16; ++o) { const f32x4 w = *(const LAS f32x4*)(wab + o * 1024 + 4 * F.lane + 256 * j + fence); acc[o] += (v[j].x * w.x + v[j].y * w.y) + (v[j].z * w.z + v[j].w * w.w); } }
                const bool b5 = F.lane & 32, b4 = F.lane & 16, b3 = F.lane & 8, b2 = F.lane & 4;
                float r8[8], r4[4], r2[2];
#pragma unroll
                for (int o = 0; o < 8; ++o) { const float mine = b5 ? acc[o + 8] : acc[o], oth = b5 ? acc[o] : acc[o + 8]; r8[o] = mine + __shfl_xor(oth, 32); }
#pragma unroll
                for (int o = 0; o < 4; ++o) { const float mine = b4 ? r8[o + 4] : r8[o], oth = b4 ? r8[o] : r8[o + 4]; r4[o] = mine + __shfl_xor(oth, 16); }
#pragma unroll
                for (int o = 0; o < 2; ++o) { const float mine = b3 ? r4[o + 2] : r4[o], oth = b3 ? r4[o] : r4[o + 2]; r2[o] = mine + __shfl_xor(oth, 8); }
                float r1 = (b2 ? r2[1] : r2[0]) + __shfl_xor(b2 ? r2[0] : r2[1], 4);
                r1 += __shfl_xor(r1, 2); r1 += __shfl_xor(r1, 1);
                float abq[4];
#pragma unroll
                for (int q = 0; q < 4; ++q) abq[q] = __shfl(r1, (F.lane & 12) | (q << 4));
                if ((F.lane & 0x33) == 0) { const int h = F.lane >> 2;
                    const float af = abq[0], bfv = abq[1], abk = abq[2], bb = abq[3];
                    const float* alog = F.in[I_ALOG]; const float* dtb = F.in[I_DTB];
                    const float xf = af + dtb[h], xb = abk + dtb[4 + h];
                    const float spf = xf > 20.f ? xf : log1pf(expf(xf)), spb = xb > 20.f ? xb : log1pf(expf(xb));
                    float* gsc = (float*)(F.ws + WS_GSC);
                    gsc[(size_t)m * 4 + h] = -expf(alog[h]) * spf;
                    gsc[(size_t)T * 4 + (size_t)m * 4 + h] = 1.0f / (1.0f + expf(-bfv));
                    gsc[(size_t)2 * T * 4 + (size_t)m * 4 + h] = -expf(alog[4 + h]) * spb;
                    gsc[(size_t)3 * T * 4 + (size_t)m * 4 + h] = 1.0f / (1.0f + expf(-bb));
                }
            }
        }
}
template <int MODE>
__device__ __forceinline__ void norm_setup(Frame& F, LAS float* wab) {
    if (MODE == 1) {
        const float* W = F.in[I_WMI];
        f32x4 t[8];
#pragma unroll
        for (int i = 0; i < 8; ++i) { const int idx4 = F.tid + i * (NWAVES * 64); t[i] = *(const f32x4*)(W + (size_t)(idx4 >> 2) * PROJ + NMIX + 4 * (idx4 & 3)); }
#pragma unroll
        for (int i = 0; i < 8; ++i) { const int idx4 = F.tid + i * (NWAVES * 64), k = idx4 >> 2, o = 4 * (idx4 & 3);
            const int pos = 4 * ((k & 511) >> 3) + 256 * (2 * (k >> 9) + ((k >> 2) & 1)) + (k & 3);
            wab[(o + 0) * 1024 + pos] = t[i].x; wab[(o + 1) * 1024 + pos] = t[i].y; wab[(o + 2) * 1024 + pos] = t[i].z; wab[(o + 3) * 1024 + pos] = t[i].w; }
        __syncthreads();
    }
}
template <int MODE>
__device__ __forceinline__ void norm_phase(Frame& F, const float* src0, const float* src1, const float* gnorm, int off_shift, int off_scale, bf16* H) {
    const int gw = F.vcu * NWAVES + F.wave, NGW = F.G * NWAVES;
    LAS float* wab = (LAS float*)F.lds;
    norm_setup<MODE>(F, wab);
    const float* mod = (const float*)(F.ws + WS_MOD);
    f32x4 gv[4];
#pragma unroll
    for (int j = 0; j < 4; ++j) gv[j] = *(const f32x4*)(gnorm + NIDX(F.lane, j));
    const int per = (T + NGW - 1) / NGW, mbeg = gw * per, mend = (mbeg + per < T) ? mbeg + per : T;
    RowBuf<false> cur, nxt; ModVec mv; mv.midx = -1;
    if (mbeg < mend) norm_fetch<false>(cur, mbeg, src0, src1, F.lane);
#pragma unroll 1
    for (int m = mbeg; m < mend; ++m) { const bool more = m + 1 < mend; if (more) norm_fetch<false>(nxt, m + 1, src0, src1, F.lane);
        if (MODE != 2) mod_fetch(mv, m, mod, off_shift, off_scale, F.lane);
        norm_row<MODE, false>(F, m, cur, gv, mv, H, wab); if (more) cur = nxt; }
}
template <class Order>
__device__ __forceinline__ void publish_units(Frame& F, const Order& S, gu32* ready) {
    if (F.tid == 0) {
        __builtin_amdgcn_fence(__ATOMIC_RELEASE, "agent");
        asm volatile("s_waitcnt vmcnt(0)" ::: "memory");
        pg8::Unit u; for (int i = 0; S.next(i, u); ++i) __hip_atomic_fetch_add(ready + 64 * u.pm, 1u, RLX_AGENT);
    }
}
template <int MODE, bool SB>
__device__ __forceinline__ void norm_rows(Frame& F, const void* src0, const void* src1, const float* gnorm, int off_shift, int off_scale, bf16* H, int m0, int m1, int wi, int nw, int rows_per_wave, gu32* ready, bool setup = true) {
    LAS float* wab = (LAS float*)F.lds;
    if (setup) norm_setup<MODE>(F, wab);
    if (wi < 0) return;
    const float* mod = (const float*)(F.ws + WS_MOD);
    f32x4 gv[4];
#pragma unroll
    for (int j = 0; j < 4; ++j) gv[j] = *(const f32x4*)(gnorm + NIDX(F.lane, j));
    (void)ready;
    const int step = nw * rows_per_wave;
    int mb = m0 + wi * rows_per_wave, m = mb;
    RowBuf<SB> cur, nxt; ModVec mv; mv.midx = -1;
    if (m < m1) norm_fetch<SB>(cur, m, src0, src1, F.lane);
#pragma unroll 1
    while (m < m1) {
        int m2 = m + 1, mb2 = mb; if (m2 >= mb + rows_per_wave || m2 >= m1) { mb2 = mb + step; m2 = mb2; }
        const bool more = m2 < m1; if (more) norm_fetch<SB>(nxt, m2, src0, src1, F.lane);
        if (MODE != 2) mod_fetch(mv, m, mod, off_shift, off_scale, F.lane);
        norm_row<MODE, SB>(F, m, cur, gv, mv, H, wab);
        if (more) cur = nxt;
        m = m2; mb = mb2;
    }
}
__device__ __forceinline__ void tail_publish(Frame& F, gu32* ctr) {
    asm volatile("s_waitcnt vmcnt(0)" ::: "memory");
    __syncthreads();
    if (F.tid == 0) { __builtin_amdgcn_fence(__ATOMIC_RELEASE, "agent"); asm volatile("s_waitcnt vmcnt(0)" ::: "memory"); __hip_atomic_fetch_add(ctr, 1u, RLX_AGENT); }
}
__device__ __forceinline__ void panel_wait(Frame& F, gu32* rp, unsigned need) {
    if (F.wave == 0) { unsigned spins = 0;
        while ((unsigned)__builtin_amdgcn_readfirstlane(__hip_atomic_load(rp, RLX_AGENT)) < need) { __builtin_amdgcn_s_sleep(8); if (++spins > (1u << 22)) break; }
        __builtin_amdgcn_fence(__ATOMIC_ACQUIRE, "agent");
        asm volatile("s_waitcnt vmcnt(0)" ::: "memory"); }
    __syncthreads();
}
__device__ __forceinline__ void xcd_publish(Frame& F, gu32* xsub, unsigned expected_local, gu32* gctr) {
    asm volatile("s_waitcnt vmcnt(0)" ::: "memory");
    __syncthreads();
    if (F.tid == 0) {
        const unsigned old = __hip_atomic_fetch_add(xsub + 64 * F.xcc, 1u, RLX_AGENT);
        if (old + 1u == expected_local) { __builtin_amdgcn_fence(__ATOMIC_RELEASE, "agent"); asm volatile("s_waitcnt vmcnt(0)" ::: "memory"); __hip_atomic_fetch_add(gctr, expected_local, RLX_AGENT); }
    }
}

typedef float f32x16 __attribute__((ext_vector_type(16)));
typedef __bf16 bf16x2_t __attribute__((ext_vector_type(2)));
typedef float f32x2_t __attribute__((ext_vector_type(2)));
#define MFMA32(a, b, c) __builtin_amdgcn_mfma_f32_32x32x16_bf16((a), (b), (c), 0, 0, 0)
__device__ __forceinline__ unsigned pkc(float lo, float hi) { f32x2_t v = {lo, hi}; bf16x2_t b = __builtin_convertvector(v, bf16x2_t); return __builtin_bit_cast(unsigned, b); }
__device__ __forceinline__ float rdlane(float v, int l) { return __builtin_bit_cast(float, __builtin_amdgcn_readlane(__builtin_bit_cast(int, v), l)); }
__device__ __forceinline__ float silu_fast(float a) { return a * __builtin_amdgcn_rcpf(1.0f + __expf(-a)); }
__device__ __forceinline__ int opaque(int x) { asm volatile("" : "+v"(x)); return x; }
__device__ __forceinline__ float opaquef(float x) { asm volatile("" : "+v"(x)); return x; }
__device__ __forceinline__ int crow(int r, int hh) { return (r & 3) + 8 * (r >> 2) + 4 * hh; }

constexpr int NCHUNK = T / 64;
constexpr size_t WS_QA = 342 * MiB, WS_KA = 378 * MiB, WS_KTA = 414 * MiB, WS_VACC = 450 * MiB;
constexpr size_t WS_TAF = 486 * MiB, WS_SC = 504 * MiB;
constexpr size_t WS_TAB = 50 * MiB, WS_QKAF = 68 * MiB, WS_QKAB = 86 * MiB;
__device__ __forceinline__ size_t o_off(int dir, int g) { return (g < TP / 64 ? (104 + 4 * (size_t)dir) * MiB : (238 + 32 * (size_t)dir) * MiB) + (size_t)g * 65536; }
static_assert(WS_SC + (size_t)NCHUNK * NH * 384 * 4 <= WS_END, "DN scalars vs workspace end");

__device__ __forceinline__ void store_rows_as_afrags(const float (&M)[64], bf16* dst, int lane) {
#pragma unroll
    for (int ks = 0; ks < 4; ++ks) {
        unsigned pa[4], pb[4];
        pa[0] = pkc(M[16 * ks + 0], M[16 * ks + 1]); pa[1] = pkc(M[16 * ks + 2], M[16 * ks + 3]); pa[2] = pkc(M[16 * ks + 8], M[16 * ks + 9]); pa[3] = pkc(M[16 * ks + 10], M[16 * ks + 11]);
        pb[0] = pkc(M[16 * ks + 4], M[16 * ks + 5]); pb[1] = pkc(M[16 * ks + 6], M[16 * ks + 7]); pb[2] = pkc(M[16 * ks + 12], M[16 * ks + 13]); pb[3] = pkc(M[16 * ks + 14], M[16 * ks + 15]);
#pragma unroll
        for (int q = 0; q < 4; ++q) { const auto r = __builtin_amdgcn_permlane32_swap(pa[q], pb[q], false, false); pa[q] = r[0]; pb[q] = r[1]; }
        v4u fa = {pa[0], pa[1], pa[2], pa[3]}, fb = {pb[0], pb[1], pb[2], pb[3]};
        *(v4u*)((char*)dst + (unsigned)lane * 16u + ks * 1024) = fa;
        *(v4u*)((char*)dst + 4096 + (unsigned)lane * 16u + ks * 1024) = fb;
        __builtin_amdgcn_sched_barrier(0);
    }
}

__device__ __forceinline__ void conv4(const v2u x0, const v2u x1, const v2u x2, const f32x4 w0, const f32x4 w1, const f32x4 w2, float (&o)[4]) {
    o[0] = silu_fast(w0.x * bflo(x0.x) + w1.x * bflo(x1.x) + w2.x * bflo(x2.x));
    o[1] = silu_fast(w0.y * bfhi(x0.x) + w1.y * bfhi(x1.x) + w2.y * bfhi(x2.x));
    o[2] = silu_fast(w0.z * bflo(x0.y) + w1.z * bflo(x1.y) + w2.z * bflo(x2.y));
    o[3] = silu_fast(w0.w * bfhi(x0.y) + w1.w * bfhi(x1.y) + w2.w * bfhi(x2.y));
}
__device__ __forceinline__ void stage_raw_tile(const bf16* raw, const float* cw, LAS unsigned char* sl, int m0, int p0, int L, int tok0, int colbase, int lane) {
        v4u st[9];
#pragma unroll
        for (int i = 0; i < 9; ++i) { const int pidx = lane + 64 * i, row = pidx >> 4, c16 = pidx & 15, t = tok0 - 1 + row;
            const bool ok = pidx < 544 && p0 + t >= 0 && p0 + t < L;
            st[i] = ok ? *(const v4u*)((const char*)raw + ((size_t)(m0 + t) * 1536 + colbase) * 2 + c16 * 16) : (v4u){0u, 0u, 0u, 0u}; }
        f32x4 wt[2];
#pragma unroll
        for (int i = 0; i < 2; ++i) { const int idx4 = lane + 64 * i; wt[i] = idx4 < 96 ? *(const f32x4*)(cw + (idx4 >> 5) * 1536 + colbase + 4 * (idx4 & 31)) : (f32x4){0.f, 0.f, 0.f, 0.f}; }
#pragma unroll
        for (int i = 0; i < 9; ++i) { const int pidx = lane + 64 * i, row = pidx >> 4, c16 = pidx & 15;
            if (pidx < 544) { LAS v2u* d = (LAS v2u*)(sl + row * 264 + c16 * 16); d[0] = (v2u){st[i].x, st[i].y}; d[1] = (v2u){st[i].z, st[i].w}; } }
#pragma unroll
        for (int i = 0; i < 2; ++i) { const int idx4 = lane + 64 * i; if (idx4 < 96) ((LAS f32x4*)(sl + 8976))[idx4] = wt[i]; }
    }
__device__ __forceinline__ void load_norm_tile(const bf16* raw, const float* cw, LAS unsigned char* sl, int m0, int p0, int L, int tok0, int colbase, int lane, float scale, bf16x8 (&frag)[8]) {
    const int r32 = lane & 31, hh = lane >> 5;
    stage_raw_tile(raw, cw, sl, m0, p0, L, tok0, colbase, lane);
    float f[8][8]; float ss = 0.f;
    const LAS unsigned char* rp = sl + r32 * 264 + 8 * hh;
    const LAS float* wp = (const LAS float*)(sl + 8976) + 4 * hh;
    int fence = 0;
#pragma unroll
    for (int ks = 0; ks < 8; ++ks) {
        asm volatile("" : "+v"(fence), "+v"(ss));
#pragma unroll
        for (int pc = 0; pc < 2; ++pc) { const int cb = 32 * ks + 16 * pc;
            const v2u x0 = *(const LAS v2u*)(rp + cb + fence), x1 = *(const LAS v2u*)(rp + 264 + cb + fence), x2 = *(const LAS v2u*)(rp + 528 + cb + fence);
            const f32x4 w0 = *(const LAS f32x4*)(wp + cb / 2), w1 = *(const LAS f32x4*)(wp + 128 + cb / 2), w2 = *(const LAS f32x4*)(wp + 256 + cb / 2);
            float o[4]; conv4(x0, x1, x2, w0, w1, w2, o);
#pragma unroll
            for (int e = 0; e < 4; ++e) { f[ks][4 * pc + e] = o[e]; ss += o[e] * o[e]; } }
    }
    ss += __shfl_xor(ss, 32);
    const float rn = scale * __builtin_amdgcn_rsqf(ss + EPS);
#pragma unroll
    for (int ks = 0; ks < 8; ++ks) { v4u p; p.x = pkc(f[ks][0] * rn, f[ks][1] * rn); p.y = pkc(f[ks][2] * rn, f[ks][3] * rn); p.z = pkc(f[ks][4] * rn, f[ks][5] * rn); p.w = pkc(f[ks][6] * rn, f[ks][7] * rn);
        frag[ks] = __builtin_bit_cast(bf16x8, p); }
}

template <int J, int C0, bool FAKE>
__device__ __forceinline__ void subst_chunk(float (&M)[64], float negl, int lo, int hi) {
    float t[8];
#pragma unroll
    for (int e = 0; e < 8; ++e) if (C0 + e >= lo && C0 + e <= hi) t[e] = FAKE ? M[C0 + e] * 0.5f : rdlane(M[C0 + e], J);
    __builtin_amdgcn_sched_barrier(0);
#pragma unroll
    for (int e = 0; e < 8; ++e) if (C0 + e >= lo && C0 + e <= hi) M[C0 + e] = fmaf(negl, t[e], M[C0 + e]);
    __builtin_amdgcn_sched_barrier(0);
}
template <int J, int LO, int HI, bool FAKE, int C0 = 0>
__device__ __forceinline__ void subst_row(float (&M)[64], float negl) {
    if constexpr (C0 < 64) { if constexpr (C0 + 7 >= LO && C0 <= HI) subst_chunk<J, C0, FAKE>(M, negl, LO, HI); subst_row<J, LO, HI, FAKE, C0 + 8>(M, negl); }
}
template <bool FAKE, int J = 0>
__device__ __forceinline__ void subst_fwd(float (&M)[64], const float (&L)[64], int lane) {
    if constexpr (J < 63) { M[J] = lane == J ? 1.f : 0.f; subst_row<J, 0, J, FAKE>(M, -L[J]); subst_fwd<FAKE, J + 1>(M, L, lane); }
}
template <bool FAKE, int J = 63>
__device__ __forceinline__ void subst_bwd(float (&M)[64], const LAS float* stash, float bbw, float gcb, int lane) {
    if constexpr (J > 0) { const float lbv = bbw * stash[J * 64] * __expf(fminf(gcb - rdlane(gcb, J), 0.f)); const float lb = lane < J ? lbv : 0.f; M[J] = lane == J ? 1.f : 0.f;
        subst_row<J, J, 63, FAKE>(M, -lb); subst_bwd<FAKE, J - 1>(M, stash, bbw, gcb, lane); }
}

template <int DM>
__device__ __forceinline__ void prep_v_images(Frame& F, const bf16* raw, const float* cw, int m0, int p0, int L, int h, size_t gh, int lane) {
    if constexpr (!(DM & 4)) {
        bf16* VA = (bf16*)(F.ws + WS_VACC) + gh * 8192;
        LAS unsigned char* sl = F.lds + F.wave * 16384;
#pragma unroll 1
        for (int I = 0; I < 2; ++I) {
            stage_raw_tile(raw, cw, sl, m0, p0, L, 32 * I, 1024 + 128 * h, lane);
            asm volatile("s_waitcnt lgkmcnt(0)" ::: "memory");
#pragma unroll 1
            for (int pass = 0; pass < 2; ++pass) { const int d = 64 * pass + lane;
                const LAS float* wp = (const LAS float*)(sl + 8976) + d;
                const float w0 = wp[0], w1 = wp[128], w2 = wp[256];
                const LAS unsigned short* cp = (const LAS unsigned short*)sl + d;
                float xm = bf2f(cp[0]), xc = bf2f(cp[132]);
                float vv[32];
#pragma unroll
                for (int t = 0; t < 32; ++t) { const float xn = bf2f(cp[132 * (t + 2)]); vv[t] = silu_fast(w0 * xm + w1 * xc + w2 * xn); xm = xc; xc = xn; }
#pragma unroll
                for (int hp = 0; hp < 2; ++hp) { unsigned pk[8];
#pragma unroll
                    for (int q = 0; q < 8; ++q) { const int r0 = 2 * q, r1 = 2 * q + 1; pk[q] = pkc(vv[(r0 & 3) + 8 * (r0 >> 2) + 4 * hp], vv[(r1 & 3) + 8 * (r1 >> 2) + 4 * hp]); }
                    bf16* dst = VA + (size_t)((d >> 5) * 2 + I) * 1024 + ((d & 31) + 32 * hp) * 8;
                    *(v4u*)dst = (v4u){pk[0], pk[1], pk[2], pk[3]}; *(v4u*)(dst + 512) = (v4u){pk[4], pk[5], pk[6], pk[7]}; }
            }
            asm volatile("s_waitcnt lgkmcnt(0)" ::: "memory");
        }
    }
}

template <int DM>
__device__ __forceinline__ void dn_prep_item(Frame& F, int item) {
    const int g = item >> 2, h = item & 3, lane = opaque(F.lane), r32 = lane & 31, hh = lane >> 5;
    const int m0 = 64 * g;
    int L, p0; if (m0 < TP) { L = L_P; p0 = m0 & (L_P - 1); } else { L = L_S; p0 = (m0 - TP) & (L_S - 1); }
    const bf16* raw = (const bf16*)(F.ws + WS_QKV);
    const float* cw = F.in[I_DNCONVW];
    const size_t gh = (size_t)g * NH + h;
    bf16* KA = (bf16*)(F.ws + WS_KA) + gh * 8192; bf16* QA = (bf16*)(F.ws + WS_QA) + gh * 8192; bf16* KTA = (bf16*)(F.ws + WS_KTA) + gh * 8192;
    const bool v_first = !(F.wave & 1);
    if (v_first) prep_v_images<DM>(F, raw, cw, m0, p0, L, h, gh, lane);
    bf16x8 kf[2][8];
    LAS unsigned char* sl = F.lds + F.wave * 16384;
#pragma unroll
    for (int I = 0; I < 2; ++I) { const int tok = 32 * I + r32;
        load_norm_tile(raw, cw, sl, m0, p0, L, 32 * I, 512 + 128 * h, lane, 1.0f, kf[I]);
        { char* kab = (char*)KA + (size_t)I * 8192; const unsigned lo16 = (unsigned)lane * 16u;
#pragma unroll
          for (int ks = 0; ks < 8; ++ks) *(bf16x8*)(kab + lo16 + ks * 1024) = kf[I][ks]; }
        if constexpr (!(DM & 8)) { const int x = tok & 15, hp = (x >> 2) & 1, jp = 4 * (x >> 3) + (x & 3), kl = (tok >> 4) & 1;
          LAS unsigned char* img = sl + (unsigned)(((kl * 64 + 4 * hh + 32 * hp) * 8 + jp) * 2);
#pragma unroll
          for (int ks = 0; ks < 8; ++ks) {
#pragma unroll
            for (int j = 0; j < 8; ++j) *(LAS unsigned short*)(img + (ks >> 1) * 2048 + (16 * (ks & 1) + 8 * (j >> 2) + (j & 3)) * 16) = (unsigned short)kf[I][ks][j]; }
          v4u pc[8];
#pragma unroll
          for (int i = 0; i < 8; ++i) pc[i] = *(const LAS v4u*)(sl + i * 1024 + lane * 16);
#pragma unroll
          for (int i = 0; i < 8; ++i) *(v4u*)((char*)KTA + (size_t)(((i >> 1) * 4 + 2 * I + (i & 1)) * 1024) + lane * 16) = pc[i];
          __builtin_amdgcn_sched_barrier(0); }

    }
    const float* gsc = (const float*)(F.ws + WS_GSC);
    const size_t mrow = (size_t)(m0 + lane) * 4 + h;
    const float gf = gsc[mrow], bfw = gsc[(size_t)T * 4 + mrow], gb = gsc[(size_t)2 * T * 4 + mrow], bbw = gsc[(size_t)3 * T * 4 + mrow];
    float gcf = gf, pb = gb;
#pragma unroll
    for (int o = 1; o < 64; o <<= 1) { const float y = __shfl_up(gcf, o), y2 = __shfl_up(pb, o); if (lane >= o) { gcf += y; pb += y2; } }
    const float gcb = rdlane(pb, 63) - pb + gb;
    float* SC = (float*)(F.ws + WS_SC) + gh * 384;
    { const float glf = rdlane(gcf, 63), glb = rdlane(gcb, 0);
      SC[lane] = __expf(gcf); SC[64 + lane] = __expf(glf - gcf); if (lane == 0) SC[128] = __expf(glf);
      SC[192 + lane] = __expf(gcb); SC[256 + lane] = __expf(glb - gcb); if (lane == 0) SC[320] = __expf(glb); }
    LAS float* stw = (LAS float*)(F.lds + F.wave * 16384);
    LAS float* stash = stw + lane;
    {
        bf16x8 qf[2][8];
#pragma unroll
        for (int Ic = 0; Ic < 2; ++Ic) {
            load_norm_tile(raw, cw, sl, m0, p0, L, 32 * Ic, 128 * h, lane, 0.08838834764831845f, qf[Ic]);
            { char* qab = (char*)QA + (size_t)Ic * 8192; const unsigned lo16 = (unsigned)lane * 16u;
#pragma unroll
              for (int ks = 0; ks < 8; ++ks) *(bf16x8*)(qab + lo16 + ks * 1024) = qf[Ic][ks]; }
            __builtin_amdgcn_sched_barrier(0); }
#pragma unroll
        for (int Ic = 0; Ic < 2; ++Ic) {
#pragma unroll
            for (int Jr = 0; Jr < 2; ++Jr) { f32x16 a = {0};
#pragma unroll
                for (int ks = 0; ks < 8; ++ks) a = MFMA32(kf[Jr][ks], qf[Ic][ks], a);
#pragma unroll
                for (int r = 0; r < 16; ++r) stw[(32 * Jr + (r & 3) + 8 * (r >> 2) + 4 * hh) * 64 + 32 * Ic + r32] = a[r]; }
            __builtin_amdgcn_sched_barrier(0); }
        float M[64];
        if constexpr (DM & 1) { const int l1 = opaque(lane);
#pragma unroll
            for (int j = 0; j < 64; ++j) { const float dec = __expf(fminf(gcf - rdlane(gcf, j), 0.f)); const float kv = stash[j * 64] * dec; M[j] = l1 >= j ? kv : 0.f; __builtin_amdgcn_sched_barrier(0); }
            store_rows_as_afrags(M, (bf16*)(F.ws + WS_QKAF) + gh * 4096, lane); }
        if constexpr (DM & 2) { const int l2 = opaque(lane);
#pragma unroll
            for (int j = 0; j < 64; ++j) { const float dec = __expf(fminf(gcb - rdlane(gcb, j), 0.f)); const float kv = stash[j * 64] * dec; M[j] = l2 <= j ? kv : 0.f; __builtin_amdgcn_sched_barrier(0); }
            store_rows_as_afrags(M, (bf16*)(F.ws + WS_QKAB) + gh * 4096, lane); }
    }
    __builtin_amdgcn_sched_barrier(0);
    float Lf[64];
    {
#pragma unroll
        for (int Ic = 0; Ic < 2; ++Ic)
#pragma unroll
            for (int Jr = 0; Jr < 2; ++Jr) { f32x16 a = {0};
#pragma unroll
                for (int ks = 0; ks < 8; ++ks) a = MFMA32(kf[Jr][ks], kf[Ic][ks], a);
#pragma unroll
                for (int r = 0; r < 16; ++r) stw[(32 * Jr + (r & 3) + 8 * (r >> 2) + 4 * hh) * 64 + 32 * Ic + r32] = a[r]; }
        __builtin_amdgcn_sched_barrier(0);
        if constexpr (DM & 1) { const int l3 = opaque(lane); const float gcf3 = opaquef(gcf);
#pragma unroll
            for (int j = 0; j < 64; ++j) { const float df = __expf(fminf(gcf3 - rdlane(gcf3, j), 0.f));
                const float kv = bfw * stash[j * 64] * df; Lf[j] = l3 > j ? kv : 0.f; __builtin_amdgcn_sched_barrier(0); } }
    }
    if constexpr (DM & 1) {
        float M[64]; const int l4 = opaque(lane);
        M[63] = l4 == 63 ? 1.f : 0.f;
        subst_fwd<(DM & 16) != 0>(M, Lf, l4);
#pragma unroll
        for (int j = 0; j < 64; ++j) { M[j] *= rdlane(bfw, j); if ((j & 7) == 7) __builtin_amdgcn_sched_barrier(0); }
        store_rows_as_afrags(M, (bf16*)(F.ws + WS_TAF) + gh * 4096, lane);
    }
    __builtin_amdgcn_sched_barrier(0);
    if constexpr (DM & 2) {
        float M[64]; const int l5 = opaque(lane);
        M[0] = l5 == 0 ? 1.f : 0.f;
        subst_bwd<(DM & 16) != 0>(M, stash, bbw, opaquef(gcb), l5);
#pragma unroll
        for (int j = 0; j < 64; ++j) { M[j] *= rdlane(bbw, j); if ((j & 7) == 7) __builtin_amdgcn_sched_barrier(0); }
        store_rows_as_afrags(M, (bf16*)(F.ws + WS_TAB) + gh * 4096, lane);
    }
    if (!v_first) prep_v_images<DM>(F, raw, cw, m0, p0, L, h, gh, lane);
}

constexpr int SB_KA = 0, SB_QA = 16384, SB_KTA = 32768, SB_V = 49152, SB_TA = 65536, SB_QKA = 71680, SB_SC = 77824, SB_BYTES = 78592;
static_assert(2 * SB_BYTES <= LDSCTL_OFF, "scan buffers vs LDS control words");
__device__ __forceinline__ bf16x8 packB(const f32x16& x, int sh) {
    v4u p; p.x = pkc(x[8 * sh + 0], x[8 * sh + 1]); p.y = pkc(x[8 * sh + 2], x[8 * sh + 3]); p.z = pkc(x[8 * sh + 4], x[8 * sh + 5]); p.w = pkc(x[8 * sh + 6], x[8 * sh + 7]);
    return __builtin_bit_cast(bf16x8, p);
}
__device__ __forceinline__ void lds_rows16(const LAS float* base, int hh, float (&o)[16]) {
#pragma unroll
    for (int q = 0; q < 4; ++q) { const f32x4 v = *(const LAS f32x4*)(base + 8 * q + 4 * hh); o[4 * q] = v.x; o[4 * q + 1] = v.y; o[4 * q + 2] = v.z; o[4 * q + 3] = v.w; }
}
#define GLDS16(gsrc, ldst) __builtin_amdgcn_global_load_lds((const unsigned*)(gsrc), (LAS unsigned*)(ldst), 16, 0, 0)
#define GLDS4(gsrc, ldst) __builtin_amdgcn_global_load_lds((const unsigned*)(gsrc), (LAS unsigned*)(ldst), 4, 0, 0)
#ifndef SCAN_WARM
#define SCAN_WARM 0
#endif
constexpr int NLOAD = SCAN_WARM ? 3 : 4;
constexpr int SB_SINK = 2 * SB_BYTES;
static_assert(SB_SINK + 256 <= LDSCTL_OFF, "scan sink vs LDS control words");
template <int DIR, int P>
__device__ __forceinline__ void scan_piece(Frame& F, size_t gh, LAS unsigned char* B, unsigned lo16) {
    if constexpr (P < 16) GLDS16(F.ws + WS_KA + gh * 16384 + lo16 + P * 1024, B + SB_KA + P * 1024);
    else if constexpr (P < 32) GLDS16(F.ws + WS_QA + gh * 16384 + lo16 + (P - 16) * 1024, B + SB_QA + (P - 16) * 1024);
    else if constexpr (P < 48) GLDS16(F.ws + WS_KTA + gh * 16384 + lo16 + (P - 32) * 1024, B + SB_KTA + (P - 32) * 1024);
    else if constexpr (P < 64) GLDS16(F.ws + WS_VACC + gh * 16384 + lo16 + (P - 48) * 1024, B + SB_V + (P - 48) * 1024);
    else if constexpr (P < 70) { constexpr int slot = P - 64, fr = DIR ? (slot < 4 ? slot : slot + 2) : (slot < 2 ? slot : slot + 2); GLDS16(F.ws + (DIR ? WS_TAB : WS_TAF) + gh * 8192 + lo16 + fr * 1024, B + SB_TA + slot * 1024); }
    else if constexpr (P < 76) { constexpr int slot = P - 70, fr = DIR ? (slot < 4 ? slot : slot + 2) : (slot < 2 ? slot : slot + 2); GLDS16(F.ws + (DIR ? WS_QKAB : WS_QKAF) + gh * 8192 + lo16 + fr * 1024, B + SB_QKA + slot * 1024); }
    else { if (F.lane < 48) GLDS16(F.ws + WS_SC + (gh * 384 + DIR * 192) * 4 + lo16, B + SB_SC); }
}
template <int DIR, int LW, int P = LW>
__device__ __forceinline__ void scan_fill_lw(Frame& F, size_t gh, LAS unsigned char* B, unsigned lo16) {
    if constexpr (P < 77) { scan_piece<DIR, P>(F, gh, B, lo16); scan_fill_lw<DIR, LW, P + NLOAD>(F, gh, B, lo16); }
}
template <int DIR>
__device__ __forceinline__ void scan_fill(Frame& F, int lw, size_t gh, int buf) {
    const unsigned lo16 = (unsigned)F.lane * 16u;
    LAS unsigned char* B = F.lds + buf * SB_BYTES;
    if (lw == 0) scan_fill_lw<DIR, 0>(F, gh, B, lo16); else if (lw == 1) scan_fill_lw<DIR, 1>(F, gh, B, lo16); else if (lw == 2 || NLOAD == 3) scan_fill_lw<DIR, 2>(F, gh, B, lo16); else scan_fill_lw<DIR, 3>(F, gh, B, lo16);
}
template <int DIR>
__device__ __forceinline__ void scan_warm(Frame& F, size_t gh) {
    const unsigned l128 = (unsigned)F.lane * 128u; LAS unsigned char* sink = F.lds + SB_SINK;
#pragma unroll
    for (int i = 0; i < 2; ++i) { GLDS4(F.ws + WS_KA + gh * 16384 + i * 8192 + l128, sink); GLDS4(F.ws + WS_QA + gh * 16384 + i * 8192 + l128, sink);
        GLDS4(F.ws + WS_KTA + gh * 16384 + i * 8192 + l128, sink); GLDS4(F.ws + WS_VACC + gh * 16384 + i * 8192 + l128, sink); }
    GLDS4(F.ws + (DIR ? WS_TAB : WS_TAF) + gh * 8192 + l128, sink); GLDS4(F.ws + (DIR ? WS_QKAB : WS_QKAF) + gh * 8192 + l128, sink);
    if (F.lane < 6) GLDS4(F.ws + WS_SC + (gh * 384 + DIR * 192) * 4 + l128, sink);
}
#define SCAN_BAR() do { asm volatile("" ::: "memory"); __builtin_amdgcn_s_barrier(); asm volatile("" ::: "memory"); } while (0)
#define SCAN_LOADER_WAIT() asm volatile("s_waitcnt vmcnt(0)" ::: "memory")
template <int DIR>
__device__ __forceinline__ void dn_scan_block(Frame& F, int set, int b, int h) {
    const int N = set ? L_S / 64 : L_P / 64, g0 = set ? TP / 64 + b * (L_S / 64) : b * (L_P / 64);
    const int w = F.wave & 3;
    const bool loader = F.wave >= 4, warmer = SCAN_WARM && F.wave == 7;
    constexpr int AHEAD = 3;
#define GH_(st) ((size_t)(g0 + (DIR ? N - 1 - (st) : (st))) * NH + h)
#ifndef SCAN_REPS
#define SCAN_REPS 1
#endif
    f32x16 s[4];
#pragma unroll 1
    for (int rep__ = 0; rep__ < SCAN_REPS; ++rep__) {
#ifndef SCAN_PROBE
#define SCAN_PROBE 0
#endif
    const bool real__ = rep__ == SCAN_REPS - 1;
    const int lane = opaque(F.lane), r32 = lane & 31, hh = lane >> 5;
    if (warmer) { for (int st = 1; st < AHEAD && st < N; ++st) scan_warm<DIR>(F, GH_(st)); }
    else if (loader) { scan_fill<DIR>(F, w, GH_(0), 0); SCAN_LOADER_WAIT(); }
    else {
        if (set) { const float* s0 = (DIR ? F.in[I_SB] : F.in[I_SF]) + (size_t)(b * NH + h) * 128 * 128 + 32 * w + r32;
#pragma unroll
            for (int dt = 0; dt < 4; ++dt)
#pragma unroll
                for (int r = 0; r < 16; ++r) s[dt][r] = s0[(size_t)(32 * dt + crow(r, hh)) * 128];
        } else {
#pragma unroll
            for (int dt = 0; dt < 4; ++dt)
#pragma unroll
                for (int r = 0; r < 16; ++r) s[dt][r] = 0.f;
        }
    }
    SCAN_BAR();
#pragma unroll 1
    for (int step = 0; step < N; ++step) {
        const int n = DIR ? N - 1 - step : step;
        if (warmer) { if (step + AHEAD < N) scan_warm<DIR>(F, GH_(step + AHEAD)); }
        else if (loader) { if (step + 1 < N && (real__ || SCAN_PROBE != 1)) scan_fill<DIR>(F, w, GH_(step + 1), (step + 1) & 1); SCAN_LOADER_WAIT(); }
        else if (real__ || SCAN_PROBE != 2) {
            const LAS unsigned char* B = F.lds + (step & 1) * SB_BYTES;
            const unsigned lo16 = (unsigned)lane * 16u;
#define FR_(off, f) (*(const LAS bf16x8*)(B + (off) + lo16 + (f) * 1024))
            bf16x8 sB[4][2];
#pragma unroll
            for (int dt = 0; dt < 4; ++dt) { sB[dt][0] = packB(s[dt], 0); sB[dt][1] = packB(s[dt], 1); }
            f32x16 P[2], Oa[2];
            {
                constexpr int DEPTH = 4;
                bf16x8 win[DEPTH];
#define S1_OFF(i) ((((i) >> 4) ? SB_QA : SB_KA) + (((((i) >> 3) & 1) * 8 + ((i) & 7)) * 1024))
#pragma unroll
                for (int i = 0; i < DEPTH; ++i) win[i] = *(const LAS bf16x8*)(B + S1_OFF(i) + lo16);
                f32x16 acc4[2][2];
#pragma unroll
                for (int I = 0; I < 2; ++I) { acc4[I][0] = (f32x16){0}; acc4[I][1] = (f32x16){0}; }
#pragma unroll
                for (int i = 0; i < 32; ++i) { const int kq = i >> 4, I = (i >> 3) & 1, ks = i & 7;
                    acc4[I][kq] = MFMA32(win[i % DEPTH], sB[ks >> 1][ks & 1], acc4[I][kq]);
                    if (i + DEPTH < 32) win[i % DEPTH] = *(const LAS bf16x8*)(B + S1_OFF(i + DEPTH) + lo16); }
#undef S1_OFF
                P[0] = acc4[0][0]; Oa[0] = acc4[0][1]; P[1] = acc4[1][0]; Oa[1] = acc4[1][1];
                __builtin_amdgcn_sched_group_barrier(0x100, DEPTH, 0);
#pragma unroll
                for (int i = 0; i < 32 - DEPTH; ++i) { __builtin_amdgcn_sched_group_barrier(0x008, 1, 0); __builtin_amdgcn_sched_group_barrier(0x100, 1, 0); }
                __builtin_amdgcn_sched_group_barrier(0x008, DEPTH, 0);
            }
            const LAS float* SC = (const LAS float*)(B + SB_SC);
            bf16x8 inB[2][2];
#pragma unroll
            for (int I = 0; I < 2; ++I) { float eg[16]; lds_rows16(SC + 32 * I, hh, eg);
                const v4u v0 = *(const LAS v4u*)(B + SB_V + w * 4096 + I * 2048 + lane * 16), v1 = *(const LAS v4u*)(B + SB_V + w * 4096 + I * 2048 + 1024 + lane * 16);
                const unsigned vw[8] = {v0.x, v0.y, v0.z, v0.w, v1.x, v1.y, v1.z, v1.w};
#pragma unroll
                for (int r = 0; r < 16; ++r) { const float vv = (r & 1) ? bfhi(vw[r >> 1]) : bflo(vw[r >> 1]); P[I][r] = vv - eg[r] * P[I][r]; Oa[I][r] *= eg[r]; }
                inB[I][0] = packB(P[I], 0); inB[I][1] = packB(P[I], 1); }
            f32x16 V[2];
#pragma unroll
            for (int Ip = 0; Ip < 2; ++Ip) { f32x16 a = {0};
#pragma unroll
                for (int ks = 0; ks < 4; ++ks) if (DIR ? (Ip == 0 || ks >= 2) : (Ip == 1 || ks < 2)) a = MFMA32(FR_(SB_TA, Ip ? 2 + ks : ks), inB[ks >> 1][ks & 1], a);
                V[Ip] = a; }
            bf16x8 vB[2][2], vsB[2][2];
#pragma unroll
            for (int I = 0; I < 2; ++I) { float egl[16]; lds_rows16(SC + 64 + 32 * I, hh, egl);
                vB[I][0] = packB(V[I], 0); vB[I][1] = packB(V[I], 1);
#pragma unroll
                for (int r = 0; r < 16; ++r) V[I][r] *= egl[r];
                vsB[I][0] = packB(V[I], 0); vsB[I][1] = packB(V[I], 1); }
            unsigned char* Ob = F.ws + o_off(DIR, g0 + n) + (size_t)h * 16384 + w * 4096 + lane * 16;
#pragma unroll
            for (int Ip = 0; Ip < 2; ++Ip) {
#pragma unroll
                for (int ks = 0; ks < 4; ++ks) if (DIR ? (Ip == 0 || ks >= 2) : (Ip == 1 || ks < 2)) Oa[Ip] = MFMA32(FR_(SB_QKA, Ip ? 2 + ks : ks), vB[ks >> 1][ks & 1], Oa[Ip]);
                v4u o0, o1;
                o0.x = pkc(Oa[Ip][0], Oa[Ip][1]); o0.y = pkc(Oa[Ip][2], Oa[Ip][3]); o0.z = pkc(Oa[Ip][4], Oa[Ip][5]); o0.w = pkc(Oa[Ip][6], Oa[Ip][7]);
                o1.x = pkc(Oa[Ip][8], Oa[Ip][9]); o1.y = pkc(Oa[Ip][10], Oa[Ip][11]); o1.z = pkc(Oa[Ip][12], Oa[Ip][13]); o1.w = pkc(Oa[Ip][14], Oa[Ip][15]);
                *(v4u*)(Ob + Ip * 2048) = o0; *(v4u*)(Ob + Ip * 2048 + 1024) = o1; }
            const float gl = SC[128];
#pragma unroll
            for (int dt = 0; dt < 4; ++dt) { f32x16 a = s[dt] * gl;
                bf16x8 ft[4];
#pragma unroll
                for (int ks = 0; ks < 4; ++ks) ft[ks] = FR_(SB_KTA, dt * 4 + ks);
#pragma unroll
                for (int ks = 0; ks < 4; ++ks) a = MFMA32(ft[ks], vsB[ks >> 1][ks & 1], a);
                s[dt] = a; }
#undef FR_
        }
        SCAN_BAR();
    }
    }
    if (warmer) SCAN_LOADER_WAIT();
#undef GH_
    const int lane = F.lane, r32 = lane & 31, hh = lane >> 5;
    if (!loader && !set) { float* so = F.out + (size_t)T * D + (size_t)DIR * (NB_P * NH * 128 * 128) + (size_t)(b * NH + h) * 128 * 128 + 32 * w + r32;
#pragma unroll
        for (int dt = 0; dt < 4; ++dt)
#pragma unroll
            for (int r = 0; r < 16; ++r) so[(size_t)(32 * dt + crow(r, hh)) * 128] = s[dt][r]; }
}
__device__ __forceinline__ void dn_scan_phase(Frame& F) {
    const int bx = blockIdx.x;
    if (bx >= 192) return;
    int set, b, h, dir;
    if (bx < 64) { set = 1; b = bx >> 3; h = (bx >> 1) & 3; dir = bx & 1; } else { const int r = bx - 64; set = 0; b = r >> 3; h = (r >> 1) & 3; dir = r & 1;
        if (F.wave < 4) { const int item = ((b * (L_P / 64) + F.wave) * NH) + h; if (dir) dn_prep_item<2>(F, item); else dn_prep_item<1>(F, item); }
        asm volatile("s_waitcnt vmcnt(0)" ::: "memory"); __syncthreads(); }
    if (dir) dn_scan_block<1>(F, set, b, h); else dn_scan_block<0>(F, set, b, h);
}
__device__ __forceinline__ void conv_rows_queue(Frame& F) {
    const int lane = F.lane;
    const bf16* CB = (const bf16*)(F.ws + WS_CB); const bf16* UC = (const bf16*)(F.ws + WS_UC); bf16* YC = (bf16*)(F.ws + WS_YC);
    const float* cw = F.in[I_CONVW];
    float w0[8], w1[8], w2[8];
#pragma unroll
    for (int e = 0; e < 8; ++e) { w0[e] = cw[8 * lane + e]; w1[e] = cw[512 + 8 * lane + e]; w2[e] = cw[1024 + 8 * lane + e]; }
    for (;;) { const int mb = q_take(F.ctl + CW_Q_CONV, 16u, lane); if (mb >= T) break;
#pragma unroll 4
        for (int m = mb; m < mb + 16; ++m) {
            int p, dd, L;
            if (m < TP) { p = m & 255; dd = 1; L = 256; } else { p = (m - TP) & 4095; dd = 64; L = 4096; }
            const v4u z4 = {0u, 0u, 0u, 0u};
            const v4u c4 = *(const v4u*)(CB + (size_t)m * 512 + 8 * lane);
            const v4u u1 = *(const v4u*)(UC + (size_t)m * 512 + 8 * lane);
            const v4u u0 = p - dd >= 0 ? *(const v4u*)(UC + (size_t)(m - dd) * 512 + 8 * lane) : z4;
            const v4u u2 = p + dd < L ? *(const v4u*)(UC + (size_t)(m + dd) * 512 + 8 * lane) : z4;
            v4u y;
#pragma unroll
            for (int q = 0; q < 4; ++q) {
                const float lo = bflo(c4[q]) * (w0[2 * q] * bflo(u0[q]) + w1[2 * q] * bflo(u1[q]) + w2[2 * q] * bflo(u2[q]));
                const float hi = bfhi(c4[q]) * (w0[2 * q + 1] * bfhi(u0[q]) + w1[2 * q + 1] * bfhi(u1[q]) + w2[2 * q + 1] * bfhi(u2[q]));
                y[q] = pk2(lo, hi); }
            *(v4u*)(YC + (size_t)m * 512 + 8 * lane) = y;
        }
    }
}
__device__ __forceinline__ void post_phase(Frame& F) {
    const int gw = F.vcu * NWAVES + F.wave, NGW = F.G * NWAVES, lane = F.lane;
    const unsigned char* SZ = F.ws + WS_SZ; unsigned char* YD = F.ws + WS_YD;
    const float* dnn = F.in[I_DNNORM];
    const int r32 = lane & 31, hh = lane >> 5;
    LAS unsigned char* tile = F.lds + F.wave * 16384;
    float gn[4];
#pragma unroll
    for (int w = 0; w < 4; ++w) gn[w] = dnn[32 * w + r32];
    const int trow = lane >> 4, tcol = (lane & 15) * 16;
    constexpr int NIT = NCHUNK * NH * 2;
    const int nfull = NIT / NGW, rem = NIT - nfull * NGW;
#pragma unroll 1
    for (int k = 0; k <= nfull; ++k) {
        int it;
        if (k < nfull) it = gw + k * NGW; else { const int j = F.wave * F.G + F.vcu; if (j >= rem) break; it = nfull * NGW + j; }
        const int I = it & 1, h = (it >> 1) & 3, g = it >> 3;
        const size_t rowbase = ((size_t)g * 64 + 32 * I) * 1024 + 256 * h;
        v4u zz[8];
#pragma unroll
        for (int i = 0; i < 8; ++i) zz[i] = *(const v4u*)(SZ + rowbase + (size_t)(trow + 4 * i) * 1024 + tcol);
        const unsigned char* of = F.ws + o_off(0, g) + (size_t)h * 16384 + I * 2048 + lane * 16;
        const unsigned char* ob = F.ws + o_off(1, g) + (size_t)h * 16384 + I * 2048 + lane * 16;
        float o[4][16]; float ss[16];
#pragma unroll
        for (int r = 0; r < 16; ++r) ss[r] = 0.f;
#pragma unroll
        for (int w = 0; w < 4; ++w) { const v4u a0 = *(const v4u*)(of + w * 4096), a1 = *(const v4u*)(of + w * 4096 + 1024), b0 = *(const v4u*)(ob + w * 4096), b1 = *(const v4u*)(ob + w * 4096 + 1024);
            const unsigned aw[8] = {a0.x, a0.y, a0.z, a0.w, a1.x, a1.y, a1.z, a1.w}, bw[8] = {b0.x, b0.y, b0.z, b0.w, b1.x, b1.y, b1.z, b1.w};
#pragma unroll
            for (int r = 0; r < 16; ++r) { const float v = (r & 1) ? bfhi(aw[r >> 1]) + bfhi(bw[r >> 1]) : bflo(aw[r >> 1]) + bflo(bw[r >> 1]); o[w][r] = v; ss[r] += v * v; } }
#pragma unroll
        for (int i = 0; i < 8; ++i) *(LAS v4u*)(tile + (trow + 4 * i) * 264 + tcol) = zz[i];
#pragma unroll
        for (int r = 0; r < 16; ++r) { float t = ss[r]; t += __shfl_xor(t, 1); t += __shfl_xor(t, 2); t += __shfl_xor(t, 4); t += __shfl_xor(t, 8); t += __shfl_xor(t, 16); ss[r] = 1.0f / sqrtf(t * (1.f / 128.f) + EPS); }
#pragma unroll
        for (int r = 0; r < 16; ++r) { LAS unsigned short* rowp = (LAS unsigned short*)(tile + ((r & 3) + 8 * (r >> 2) + 4 * hh) * 264) + r32;
#pragma unroll
            for (int w = 0; w < 4; ++w) { const float z = bf2f(rowp[32 * w]); rowp[32 * w] = (unsigned short)f2bf(o[w][r] * ss[r] * gn[w] * z); } }
#pragma unroll
        for (int i = 0; i < 8; ++i) zz[i] = *(const LAS v4u*)(tile + (trow + 4 * i) * 264 + tcol);
#pragma unroll
        for (int i = 0; i < 8; ++i) *(v4u*)(YD + rowbase + (size_t)(trow + 4 * i) * 1024 + tcol) = zz[i];
    }
}

struct Args { const float* in[23]; float* out; unsigned char* ws; int ph_lo, ph_hi; };
__global__ void __launch_bounds__(NWAVES * 64, 2) mk_fwd(Args args) {
    extern __shared__ __attribute__((aligned(16))) unsigned char lds[];
    Frame F;
    F.lds = (LAS unsigned char*)lds;
    F.MISC = (volatile LAS unsigned*)(F.lds + MISC_OFF);
    F.tid = threadIdx.x; F.lane = F.tid & 63; F.wave = __builtin_amdgcn_readfirstlane(F.tid >> 6);
    F.G = gridDim.x; { const int bx = blockIdx.x; F.vcu = (F.G % 8 == 0) ? (bx % 8) * (F.G / 8) + bx / 8 : bx; }
    unsigned char* ws = args.ws; F.ws = ws; F.out = args.out;
    F.in = args.in;
    F.ctl = (gu32*)(ws + WS_CTL);
    for (int u = F.tid; u < (LDS_BYTES - LDSCTL_OFF) / 4; u += NWAVES * 64) ((LAS unsigned*)(F.lds + LDSCTL_OFF))[u] = 0u;
    __syncthreads();
    XcdBarrier bar; bar.bar = (unsigned*)(F.ctl + CW_BAR); bar.x = 0; bar.st = nullptr;
    const int lo = args.ph_lo, hi = args.ph_hi;
    if (hi - lo > 1) bar = xcd_barrier_post((unsigned*)(F.ctl + CW_BAR), F.MISC + 8);
    F.xcc = xb_xcc_id();
    if (F.tid == 0 && blockIdx.x < 192) __hip_atomic_fetch_add(F.ctl + CW_ECNT + 64 * F.xcc, 1u, RLX_AGENT);
#ifndef PH_MASK
#define PH_MASK 0xFFFF
#endif
#define IN(k) ((((PH_MASK) >> (k)) & 1) && lo <= (k) && (k) < hi)
#define SEAM(k) do { if (IN(k) && IN((k) + 1)) xcd_barrier(bar); } while (0)
#ifndef DUP_MASK
#define DUP_MASK 0
#endif
#define NREP(k) ((((DUP_MASK) >> (k)) & 1) ? 2 : 1)
#define REPB(k) _Pragma("unroll") for (int rep_ = 0; rep_ < NREP(k); ++rep_) { if (rep_) xcd_barrier(bar);
#define REPE }
    const float* mod = (const float*)(ws + WS_MOD);
    bf16* H = (bf16*)(ws + WS_H); bf16* ACT = (bf16*)(ws + WS_ACT);

    if (IN(0)) { REPB(0)  p0_prologue(F); REPE } SEAM(0);
#ifdef EXTRA_BARS
    for (int eb = 0; eb < EXTRA_BARS; ++eb) xcd_barrier(bar);
#endif
    if (IN(1)) { REPB(1)  norm_phase<0>(F, F.in[I_XP], F.in[I_XS], F.in[I_NF1], 0 * D, 1 * D, H); REPE } SEAM(1);
    if (IN(2)) { REPB(2)  pg8::Gemm g{H, (const bf16*)(ws + WS_WF1I), T, NFFI, D, D, H, 1 << 30}; pg8::StaticOrder S; S.init(T, NFFI, F.G, (int)blockIdx.x);
        pg8::EpiSwiglu E{ACT, FF}; pg8::gemm_phase<pg8::EpiSwiglu, pg8::StaticOrder, SWIGLU_ALIGN, GEMM_SP2>(F.lds + RING_OFF, g, S, E);
#if W2_IN_P0 == 2
        { constexpr int NLAST = (T / 256) * (NFFI / 256) - 12 * 256;
          if ((int)blockIdx.x >= NLAST && F.G == 256) ffn2_weights_static(F, (LAS float*)(F.lds + F.wave * 16384), ((int)blockIdx.x - NLAST) * NWAVES + F.wave, (256 - NLAST) * NWAVES); }
#endif
    REPE } SEAM(2);
    if (IN(3)) { pg8::Gemm g{ACT, (const bf16*)(ws + WS_WF1O), T, D, FF, FF, ACT, 1 << 30}; pg8::SplitOrder S; S.init(T, D, F.G, (int)blockIdx.x, 96 * 256, 192);
        pg8::EpiResid<false, true> E{F.in[I_XP], F.in[I_XS], TP, F.out, D, mod + 2 * D, NMOD, 0.5f}; pg8::gemm_phase<pg8::EpiResid<false, true>, pg8::SplitOrder, RESID_ALIGN, GEMM_SP2>(F.lds + RING_OFF, g, S, E);
        if (blockIdx.x < 192) { xcd_publish(F, F.ctl + CW_XPUB + 0 * 1024, __hip_atomic_load(F.ctl + CW_ECNT + 64 * F.xcc, RLX_AGENT), F.ctl + CW_EDONE + 64 * 0); panel_wait(F, F.ctl + CW_EDONE + 64 * 0, 192u); }
        if (blockIdx.x < 192) norm_rows<1, true>(F, F.out, (const bf16*)F.out + (size_t)TP * D, F.in[I_NMIX], 3 * D, 4 * D, H, 0, 96 * 256, (int)blockIdx.x * NWAVES + F.wave, 192 * NWAVES, 16, nullptr); } SEAM(3);
    if (IN(4)) { norm_rows<1, true>(F, F.out, (const bf16*)F.out + (size_t)TP * D, F.in[I_NMIX], 3 * D, 4 * D, H, NOSHADOW ? 0 : 96 * 256, T, F.vcu * NWAVES + F.wave, F.G * NWAVES, 1, nullptr, blockIdx.x >= 192 || !IN(3));        if (IN(5)) xcd_publish(F, F.ctl + CW_XPUB + 3 * 1024, F.MISC[8], F.ctl + CW_TAIL2); else {} }
    if (IN(5)) { REPB(5)  pg8::Gemm g{H, (const bf16*)(ws + WS_WMI), T, NMIX, D, D, H, 1 << 30}; pg8::TwoStageOrder S; S.init(T, NMIX, F.G, (int)blockIdx.x, 96 * 256, (const unsigned*)(F.ctl + CW_TAIL2), IN(4) ? (unsigned)F.G : 0u);
        pg8::EpiMixIn E{(bf16*)(ws + WS_CB), (bf16*)(ws + WS_UC), (bf16*)(ws + WS_QKV), (bf16*)(ws + WS_SZ)}; pg8::gemm_phase<pg8::EpiMixIn, pg8::TwoStageOrder, true, GEMM_SP2>(F.lds + RING_OFF, g, S, E); REPE } SEAM(5);
    if (IN(6)) { REPB(6)  for (int it = (TP / 64) * NH + F.wave * F.G + (int)blockIdx.x; it < NCHUNK * NH; it += NWAVES * F.G) { if (rep_ + 1 < NREP(6)) dn_prep_item<PREP_PROBE_DM>(F, it); else dn_prep_item<3>(F, it); }
#if W2_IN_P0 == 0
        ffn2_weights_queue(F, (LAS float*)(F.lds + F.wave * 16384));
#endif
    REPE } SEAM(6);
    if (IN(7)) { REPB(7)
        dn_scan_phase(F);
#if CONV_IN_SCAN
        if (blockIdx.x >= 64) conv_rows_queue(F);
#endif
    REPE } SEAM(7);
    if (IN(8)) { REPB(8)
#if !CONV_IN_SCAN
        conv_rows_queue(F);
#endif
        post_phase(F); REPE } SEAM(8);
    if (IN(9)) { pg8::Gemm g{(const bf16*)(ws + WS_YC), (const bf16*)(ws + WS_WMO), T, D, D, 512, (const bf16*)(ws + WS_YD) - 8 * 64, 8}; pg8::SplitOrder S; S.init(T, D, F.G, (int)blockIdx.x, 96 * 256, 192);
        pg8::EpiResid<true, true> E{F.out, (const bf16*)F.out + (size_t)TP * D, TP, ws + WS_X2B, D, mod + 5 * D, NMOD, 1.0f}; pg8::gemm_phase<pg8::EpiResid<true, true>, pg8::SplitOrder, RESID_ALIGN, GEMM_SP2, true>(F.lds + RING_OFF, g, S, E);
        if (blockIdx.x < 192) { xcd_publish(F, F.ctl + CW_XPUB + 1 * 1024, __hip_atomic_load(F.ctl + CW_ECNT + 64 * F.xcc, RLX_AGENT), F.ctl + CW_EDONE + 64 * 1); panel_wait(F, F.ctl + CW_EDONE + 64 * 1, 192u); }
        norm_rows<0, true>(F, ws + WS_X2B, (const bf16*)(ws + WS_X2B) + (size_t)TP * D, F.in[I_NF2], 6 * D, 7 * D, (bf16*)(ws + WS_H3), 0, 96 * 256, NOSHADOW ? -1 : (blockIdx.x < 192 ? (int)blockIdx.x * NWAVES + F.wave : -1), 192 * NWAVES, 16, nullptr); } SEAM(9);
    if (IN(10)) { norm_rows<0, true>(F, ws + WS_X2B, (const bf16*)(ws + WS_X2B) + (size_t)TP * D, F.in[I_NF2], 6 * D, 7 * D, (bf16*)(ws + WS_H3), NOSHADOW ? 0 : 96 * 256, T, F.vcu * NWAVES + F.wave, F.G * NWAVES, 1, nullptr); if (IN(11)) xcd_publish(F, F.ctl + CW_XPUB + 4 * 1024, F.MISC[8], F.ctl + CW_TAIL3); else {} }
    if (IN(11)) { REPB(11)  pg8::Gemm g{(const bf16*)(ws + WS_H3), (const bf16*)(ws + WS_WF2I), T, NFFI, D, D, (const bf16*)(ws + WS_H3), 1 << 30}; pg8::TwoStageOrder S; S.init(T, NFFI, F.G, (int)blockIdx.x, 96 * 256, (const unsigned*)(F.ctl + CW_TAIL3), IN(10) ? (unsigned)F.G : 0u);
        pg8::EpiSwiglu E{ACT, FF}; pg8::gemm_phase<pg8::EpiSwiglu, pg8::TwoStageOrder, SWIGLU_ALIGN, GEMM_SP2>(F.lds + RING_OFF, g, S, E); REPE } SEAM(11);
    if (IN(12)) { pg8::Gemm g{ACT, (const bf16*)(ws + WS_WF2O), T, D, FF, FF, ACT, 1 << 30}; pg8::SplitOrder S; S.init(T, D, F.G, (int)blockIdx.x, 96 * 256, 192);
        pg8::EpiResid<true, true> E{ws + WS_X2B, (const bf16*)(ws + WS_X2B) + (size_t)TP * D, TP, ws + WS_X2B, D, mod + 8 * D, NMOD, 0.5f}; pg8::gemm_phase<pg8::EpiResid<true, true>, pg8::SplitOrder,        RESID_ALIGN, GEMM_SP2>(F.lds + RING_OFF, g, S, E);
        if (blockIdx.x < 192) { xcd_publish(F, F.ctl + CW_XPUB + 2 * 1024, __hip_atomic_load(F.ctl + CW_ECNT + 64 * F.xcc, RLX_AGENT), F.ctl + CW_EDONE + 64 * 2); panel_wait(F, F.ctl + CW_EDONE + 64 * 2, 192u); }
        norm_rows<2, true>(F, ws + WS_X2B, (const bf16*)(ws + WS_X2B) + (size_t)TP * D, F.in[I_NFIN], 0, 0, nullptr, 0, 96 * 256, NOSHADOW ? -1 : (blockIdx.x < 192 ? (int)blockIdx.x * NWAVES + F.wave : -1), 192 * NWAVES, 16, nullptr); } SEAM(12);
    if (IN(13)) { norm_rows<2, true>(F, ws + WS_X2B, (const bf16*)(ws + WS_X2B) + (size_t)TP * D, F.in[I_NFIN], 0, 0, nullptr, NOSHADOW ? 0 : 96 * 256, T, F.vcu * NWAVES + F.wave, F.G * NWAVES, 1, nullptr); }
#undef IN
#undef SEAM
}

extern "C" void kernel_launch(void* const* d_in, const int* in_sizes, int n_in, void* d_out, int out_size, void* d_ws, size_t ws_size, hipStream_t stream) {
    static int grid = 0;
    if (grid == 0) {
        if (n_in != 23 || ws_size < WS_END) { fprintf(stderr, "kernel_launch: need 23 inputs and >= %zu bytes of workspace; got n_in %d, ws %zu\n", (size_t)WS_END, n_in, ws_size); grid = -1; return; }
        int dev = 0, cus = 0, per_cu = 0;
        if (hipGetDevice(&dev) != hipSuccess || hipDeviceGetAttribute(&cus, hipDeviceAttributeMultiprocessorCount, dev) != hipSuccess) { grid = -1; return; }
        if (hipFuncSetAttribute((const void*)mk_fwd, hipFuncAttributeMaxDynamicSharedMemorySize, LDS_BYTES) != hipSuccess) { fprintf(stderr, "kernel_launch: hipFuncSetAttribute failed\n"); grid = -1; return; }
        if (hipOccupancyMaxActiveBlocksPerMultiprocessor(&per_cu, (const void*)mk_fwd, NWAVES * 64, LDS_BYTES) != hipSuccess || per_cu < 1) { fprintf(stderr, "kernel_launch: occupancy query says %d blocks per CU\n", per_cu); grid = -1; (void)hipGetLastError(); return; }
        grid = cus;
    }
    if (grid < 0) return;
    (void)hipMemsetAsync((char*)d_ws + WS_CTL, 0, CTL_ZERO_BYTES, stream);
    Args a{};
    for (int i = 0; i < 23; ++i) a.in[i] = (const float*)d_in[i];
    a.out = (float*)d_out; a.ws = (unsigned char*)d_ws;
#if MK_N_LAUNCHES == 1
    a.ph_lo = 0; a.ph_hi = N_PHASES;
    hipLaunchKernelGGL(mk_fwd, dim3(grid), dim3(NWAVES * 64), LDS_BYTES, stream, a);
#else
    for (int p = 0; p < N_PHASES; ++p) { a.ph_lo = p; a.ph_hi = p + 1; hipLaunchKernelGGL(mk_fwd, dim3(grid), dim3(NWAVES * 64), LDS_BYTES, stream, a); }
#endif
}
```
